# Optimizing an MI355X kernel written in HIP

```python
import math
import jax, jax.numpy as jnp
from jax import lax
import numpy as np


D_MODEL = 2048
BATCH = 32
SEQ = 256
DEPTH = 2
DEC_BATCH = 8
DEC_SEQ = 2048
PAST_LEN = 512

GRID_W = 64
D_RNN = D_MODEL
LRU_BLOCKS = 16
LRU_BLOCK = D_RNN // LRU_BLOCKS
CONV_W = 4
CONV_PAD_LEFT = 2
LRU_C = 8.0
DA_HEADS = 8
DA_QK_DIM = 64
DA_V_DIM = 128
ROT_AXIS_DIM = DA_QK_DIM // 2
ROPE_BASE = 10000.0
D_FF = ((8 * D_MODEL // 3 + 127) // 128) * 128
N_MOD = 9
Q_BLOCK = 128
NORM_EPS = 1e-6
QK_COLS = DA_HEADS * 2 * DA_QK_DIM
V_COLS = DA_HEADS * DA_V_DIM
IN_COLS = 2 * D_RNN + 2 * QK_COLS + V_COLS + 2 * D_MODEL
IN_SPLITS = (D_RNN, 2 * D_RNN, 2 * D_RNN + QK_COLS, 2 * D_RNN + 2 * QK_COLS, 2 * D_RNN + 2 * QK_COLS + V_COLS)

kernel_name = 'hybrid_rglru_diffattn_prefix_dit_step'


def rms_norm(x, g):
    xf = x.astype(jnp.float32)
    y = xf * lax.rsqrt(jnp.mean(xf * xf, axis=-1, keepdims=True) + NORM_EPS)
    return y.astype(x.dtype) * g


def swiglu(h, w1, w2):
    g, u = jnp.split(h @ w1, 2, axis=-1)
    return (jax.nn.silu(g) * u) @ w2


def axial_rope_tables(n_tokens):
    n_rows = n_tokens // GRID_W
    t = jnp.arange(n_rows * GRID_W)
    row = (t // GRID_W).astype(jnp.float32)
    col = (t % GRID_W).astype(jnp.float32)
    freqs = 1.0 / (ROPE_BASE ** (jnp.arange(0, ROT_AXIS_DIM, 2, dtype=jnp.float32) / ROT_AXIS_DIM))
    ang = jnp.stack([row[:, None] * freqs, col[:, None] * freqs], axis=1)
    return jnp.cos(ang), jnp.sin(ang)


def apply_axial_rope(x, cos, sin):
    shp = x.shape
    xa = x.reshape(shp[:-1] + (2, 2, ROT_AXIS_DIM // 2))
    c = cos[None, :, None, None].astype(x.dtype)
    s = sin[None, :, None, None].astype(x.dtype)
    x1, x2 = xa[..., 0, :], xa[..., 1, :]
    out = jnp.stack([x1 * c - x2 * s, x2 * c + x1 * s], axis=-2)
    return out.reshape(shp)


def diff_attention(q, k, v, lam):
    b, tq = q.shape[0], q.shape[1]
    nb = tq // Q_BLOCK
    qb = jnp.moveaxis(q.reshape(b, nb, Q_BLOCK, DA_HEADS, 2, DA_QK_DIM), 1, 0)
    scale = DA_QK_DIM ** -0.5
    kf = k.astype(jnp.float32)

    def one_block(qblk):
        s = jnp.einsum('bqhmd,bkhmd->bhmqk', qblk.astype(jnp.float32), kf) * scale
        p = jax.nn.softmax(s, axis=-1)
        p_diff = p[:, :, 0] - lam * p[:, :, 1]
        return jnp.einsum('bhqk,bkhd->bqhd', p_diff.astype(v.dtype), v)

    o = lax.map(one_block, qb)
    return jnp.moveaxis(o, 0, 1).reshape(b, tq, DA_HEADS, DA_V_DIM)


def block_diag(x, w, b):
    xs = x.reshape(x.shape[:-1] + (LRU_BLOCKS, LRU_BLOCK))
    return jnp.einsum('btnd,nde->btne', xs, w).reshape(x.shape) + b


def centred_depthwise_conv(x, w, b):
    t = x.shape[1]
    xp = jnp.pad(x, ((0, 0), (CONV_PAD_LEFT, CONV_W - 1 - CONV_PAD_LEFT), (0, 0)))
    return sum(w[j] * xp[:, j:j + t] for j in range(CONV_W)) + b


def rglru_coeffs(y, wa, ba, wx, bx, lam_param):
    gate_a = jax.nn.sigmoid(block_diag(y, wa, ba)).astype(jnp.float32)
    gate_x = jax.nn.sigmoid(block_diag(y, wx, bx)).astype(jnp.float32)
    log_a = -LRU_C * gate_a * jax.nn.softplus(-lam_param.astype(jnp.float32))
    a = jnp.exp(log_a)
    mult = jnp.sqrt(-jnp.expm1(2.0 * log_a))
    return a, mult * gate_x * y.astype(jnp.float32)


def _combine(left, right):
    a1, b1 = left
    a2, b2 = right
    return a1 * a2, a2 * b1 + b2


def linear_scan(a, bterm, h0, reverse):
    a_cum, b_cum = lax.associative_scan(_combine, (a, bterm), axis=1, reverse=reverse)
    return a_cum * h0.astype(jnp.float32)[:, None, :] + b_cum


def mixer(h, lp, l, ctx_k, ctx_v, ctx_state):
    latent = ctx_k is not None
    bsz, t, _ = h.shape
    x_r, g_r, q, k, v, g_m = jnp.split(h @ lp['w_in'], IN_SPLITS, axis=-1)
    y = centred_depthwise_conv(x_r, lp['conv_w'], lp['conv_b'])
    a_f, b_f = rglru_coeffs(y, lp['lru_wa'][0], lp['lru_ba'][0], lp['lru_wx'][0], lp['lru_bx'][0], lp['lru_lambda'][0])
    a_b, b_b = rglru_coeffs(y, lp['lru_wa'][1], lp['lru_ba'][1], lp['lru_wx'][1], lp['lru_bx'][1], lp['lru_lambda'][1])
    if latent:
        h0_f, h0_b = ctx_state[:, 0], ctx_state[:, 1]
    else:
        h0_f = jnp.zeros((bsz, D_RNN), jnp.float32)
        h0_b = h0_f
    hf = linear_scan(a_f, b_f, h0_f, False)
    hb = linear_scan(a_b, b_b, h0_b, True)
    rec = (hf + hb).astype(h.dtype) * jax.nn.gelu(g_r)
    q = q.reshape(bsz, t, DA_HEADS, 2, DA_QK_DIM)
    k = k.reshape(bsz, t, DA_HEADS, 2, DA_QK_DIM)
    v = v.reshape(bsz, t, DA_HEADS, DA_V_DIM)
    lam_init = 0.8 - 0.6 * math.exp(-0.3 * l)
    lam = (jnp.exp(jnp.sum(lp['lam_q1'].astype(jnp.float32) * lp['lam_k1'].astype(jnp.float32)))
           - jnp.exp(jnp.sum(lp['lam_q2'].astype(jnp.float32) * lp['lam_k2'].astype(jnp.float32))) + lam_init)
    if latent:
        cos, sin = axial_rope_tables(t)
        q_r = apply_axial_rope(q, cos, sin)
        k_r = apply_axial_rope(k, cos, sin)
        keys = jnp.concatenate([ctx_k.reshape(bsz, -1, DA_HEADS, 2, DA_QK_DIM), k_r], axis=1)
        vals = jnp.concatenate([ctx_v, v], axis=1)
        o = diff_attention(q_r, keys, vals, lam)
    else:
        o = diff_attention(q, k, v, lam)
    o = (rms_norm(o, lp['attn_subln']) * (1.0 - lam_init)).reshape(bsz, t, V_COLS)
    gm1, gm2 = jnp.split(jax.nn.sigmoid(g_m), 2, axis=-1)
    out = (gm1 * (rec @ lp['p_lru']) + gm2 * (o @ lp['p_attn'])) @ lp['w_out']
    if latent:
        return out, None
    ctx = (k.reshape(bsz, t, DA_HEADS, 2 * DA_QK_DIM), v,
           jnp.stack([hf[:, -1], hb[:, 0]], axis=1).astype(h.dtype))
    return out, ctx


def trunk_layer(x, mod, lp, l, ctx_k, ctx_v, ctx_state):
    sh1, sc1, gt1, sh2, sc2, gt2, sh3, sc3, gt3 = jnp.split(mod, N_MOD, axis=-1)
    h = rms_norm(x, lp['g_pre'][0]) * (1 + sc1) + sh1
    x = x + 0.5 * gt1 * rms_norm(swiglu(h, lp['ffn_w1'][0], lp['ffn_w2'][0]), lp['g_post'][0])
    h = rms_norm(x, lp['g_pre'][1]) * (1 + sc2) + sh2
    m, ctx = mixer(h, lp, l, ctx_k, ctx_v, ctx_state)
    x = x + gt2 * rms_norm(m, lp['g_post'][1])
    h = rms_norm(x, lp['g_pre'][2]) * (1 + sc3) + sh3
    x = x + 0.5 * gt3 * rms_norm(swiglu(h, lp['ffn_w1'][1], lp['ffn_w2'][1]), lp['g_post'][2])
    return x, ctx


def setup_inputs(seed: int = 0) -> dict:
    key = jax.random.key(seed)
    ks = jax.random.split(key, 32)
    f32 = jnp.float32

    def nrm(k, shape, scale):
        return jax.random.normal(k, shape, f32) * scale

    u = jax.random.uniform(ks[31], (DEPTH, 2, D_RNN), f32, 0.9, 0.999)
    a_base = u ** (1.0 / LRU_C)
    lru_lambda = jnp.log(a_base) - jnp.log1p(-a_base)
    return {
        'x_prompt': nrm(ks[0], (BATCH, SEQ, D_MODEL), 1.0),
        'x_sample': nrm(ks[1], (DEC_BATCH, DEC_SEQ, D_MODEL), 1.0),
        'c': nrm(ks[2], (DEC_BATCH, D_MODEL), 1.0),
        'cache_k': nrm(ks[3], (DEC_BATCH, DEPTH, PAST_LEN, DA_HEADS, 2 * DA_QK_DIM), 1.0),
        'cache_v': nrm(ks[4], (DEC_BATCH, DEPTH, PAST_LEN, DA_HEADS, DA_V_DIM), 1.0),
        'state_lru': nrm(ks[5], (DEC_BATCH, DEPTH, 2, D_RNN), 0.5),
        'c_ctx': nrm(ks[6], (D_MODEL,), 1.0),
        'w_mod': nrm(ks[7], (DEPTH, D_MODEL, N_MOD * D_MODEL), 0.5 * D_MODEL ** -0.5),
        'b_mod': nrm(ks[8], (DEPTH, N_MOD * D_MODEL), 0.02),
        'g_pre': 1.0 + nrm(ks[9], (DEPTH, 3, D_MODEL), 0.05),
        'g_post': 1.0 + nrm(ks[10], (DEPTH, 3, D_MODEL), 0.05),
        'ffn_w1': nrm(ks[11], (DEPTH, 2, D_MODEL, 2 * D_FF), D_MODEL ** -0.5),
        'ffn_w2': nrm(ks[12], (DEPTH, 2, D_FF, D_MODEL), D_FF ** -0.5),
        'w_in': nrm(ks[13], (DEPTH, D_MODEL, IN_COLS), D_MODEL ** -0.5),
        'conv_w': nrm(ks[14], (DEPTH, CONV_W, D_RNN), CONV_W ** -0.5),
        'conv_b': nrm(ks[15], (DEPTH, D_RNN), 0.02),
        'lru_wa': nrm(ks[16], (DEPTH, 2, LRU_BLOCKS, LRU_BLOCK, LRU_BLOCK), LRU_BLOCK ** -0.5),
        'lru_ba': nrm(ks[17], (DEPTH, 2, D_RNN), 0.02),
        'lru_wx': nrm(ks[18], (DEPTH, 2, LRU_BLOCKS, LRU_BLOCK, LRU_BLOCK), LRU_BLOCK ** -0.5),
        'lru_bx': nrm(ks[19], (DEPTH, 2, D_RNN), 0.02),
        'lru_lambda': lru_lambda,
        'lam_q1': nrm(ks[20], (DEPTH, DA_QK_DIM), 0.1),
        'lam_k1': nrm(ks[21], (DEPTH, DA_QK_DIM), 0.1),
        'lam_q2': nrm(ks[22], (DEPTH, DA_QK_DIM), 0.1),
        'lam_k2': nrm(ks[23], (DEPTH, DA_QK_DIM), 0.1),
        'attn_subln': 1.0 + nrm(ks[24], (DEPTH, DA_V_DIM), 0.05),
        'p_lru': nrm(ks[25], (DEPTH, D_RNN, D_MODEL), D_RNN ** -0.5),
        'p_attn': nrm(ks[26], (DEPTH, V_COLS, D_MODEL), V_COLS ** -0.5),
        'w_out': nrm(ks[27], (DEPTH, D_MODEL, D_MODEL), D_MODEL ** -0.5),
    }


def reference(x_prompt, x_sample, c, cache_k, cache_v, state_lru, c_ctx, w_mod, b_mod, g_pre, g_post,
              ffn_w1, ffn_w2, w_in, conv_w, conv_b, lru_wa, lru_ba, lru_wx, lru_bx, lru_lambda,
              lam_q1, lam_k1, lam_q2, lam_k2, attn_subln, p_lru, p_attn, w_out):
    def layer_params(l):
        return {'g_pre': g_pre[l], 'g_post': g_post[l], 'ffn_w1': ffn_w1[l], 'ffn_w2': ffn_w2[l],
                'w_in': w_in[l], 'conv_w': conv_w[l], 'conv_b': conv_b[l], 'lru_wa': lru_wa[l],
                'lru_ba': lru_ba[l], 'lru_wx': lru_wx[l], 'lru_bx': lru_bx[l], 'lru_lambda': lru_lambda[l],
                'lam_q1': lam_q1[l], 'lam_k1': lam_k1[l], 'lam_q2': lam_q2[l], 'lam_k2': lam_k2[l],
                'attn_subln': attn_subln[l], 'p_lru': p_lru[l], 'p_attn': p_attn[l], 'w_out': w_out[l]}

    x = x_prompt
    ks_, vs_, ss_ = [], [], []
    silu_ctx = jax.nn.silu(c_ctx)
    for l in range(DEPTH):
        mod = (silu_ctx @ w_mod[l] + b_mod[l])[None, None, :]
        x, (k_l, v_l, s_l) = trunk_layer(x, mod, layer_params(l), l, None, None, None)
        ks_.append(k_l)
        vs_.append(v_l)
        ss_.append(s_l)
    y_prompt = x
    new_cache_k = jnp.stack(ks_, axis=1)
    new_cache_v = jnp.stack(vs_, axis=1)
    new_state_lru = jnp.stack(ss_, axis=1)

    x = x_sample
    silu_c = jax.nn.silu(c)
    for l in range(DEPTH):
        mod = (silu_c @ w_mod[l] + b_mod[l])[:, None, :]
        x, _ = trunk_layer(x, mod, layer_params(l), l, cache_k[:, l], cache_v[:, l], state_lru[:, l])
    y_sample = x
    return (y_prompt, y_sample, new_cache_k, new_cache_v, new_state_lru)
```

```cpp
#include <hip/hip_runtime.h>
#include <cstdio>
#include <cstdint>
__device__ __forceinline__ int opaque_tid() { int t = (int)threadIdx.x; asm volatile("" : "+v"(t)); return t; }
__device__ __forceinline__ int opaque_bid() { int b = (int)blockIdx.x; asm volatile("" : "+s"(b)); return b; }
namespace pg8 {
#define PG8_LAS __attribute__((address_space(3)))
typedef unsigned short bf16_t;
typedef short bf16x8 __attribute__((ext_vector_type(8)));
typedef float f32x4 __attribute__((ext_vector_type(4)));
typedef unsigned u32x4 __attribute__((ext_vector_type(4)));
constexpr int BM = 256, BK = 64, HALF = 128, HTB = HALF * BK * 2  , STAGE_BYTES = 8 * HTB, NXCD = 8, WGM = 8;

__host__ __device__ __forceinline__ int lds_byte(int r, int c) { const int st = (r >> 4) * 2 + (c >> 5), rr = r & 15, cc = c & 31, ob = rr * 64 + cc * 2; return st * 1024 + (ob ^ (((ob >> 9) & 1) << 5)); }
__host__ __device__ __forceinline__ void stage_rc(int b, int& R, int& C) { const int st = b / 1024, sb = b % 1024, swz = sb ^ (((sb >> 9) & 1) << 5); R = (st >> 1) * 16 + swz / 64; C = (st & 1) * 32 + (swz % 64) / 2; }
__host__ __device__ __forceinline__ int perm32(int rho) { const int n = rho >> 4, i = rho & 15; return 8 * (i >> 2) + 4 * n + (i & 3); }

struct Unit { int pm, pn; };
struct Gemm { const bf16_t* A; const bf16_t* Bt; int M, N, K; };

struct StaticOrder {
    int nM, nN, nwg, G, c;
    __host__ __device__ void init(int M, int N, int G_, int c_) { nM = M / BM; nN = N / BM; nwg = nM * nN; G = G_; c = c_; }
    __host__ __device__ bool next(int i, Unit& u) const {
        const long L = (long)i * G + c; if (L >= nwg) return false;
        int wgid = (int)L; { const int q = nwg / NXCD, r = nwg % NXCD, xcd = wgid % NXCD, off = wgid / NXCD; wgid = (xcd < r ? xcd * (q + 1) : r * (q + 1) + (xcd - r) * q) + off; }
        const int nig = WGM * nN, gid = wgid / nig, fm = gid * WGM, gsz = (nM - fm) < WGM ? (nM - fm) : WGM;
        u.pm = fm + ((wgid % nig) % gsz); u.pn = (wgid % nig) / gsz; return true;
    }
    __device__ __forceinline__ void a_ready(const Unit&) const {}
    __device__ __forceinline__ void done(const Unit&) const {}
};
__device__ __forceinline__ unsigned cvt_pk_bf16(float lo, float hi) { unsigned r; asm volatile("v_cvt_pk_bf16_f32 %0, %1, %2" : "=v"(r) : "v"(lo), "v"(hi)); return r; }
typedef unsigned u32x2 __attribute__((ext_vector_type(2)));
__device__ __forceinline__ float sigm(float x) { return __builtin_amdgcn_rcpf(1.0f + __builtin_amdgcn_exp2f(-1.4426950408889634f * x)); }
__device__ __forceinline__ float gelu_tanh(float x) { return x * sigm(1.5957691216057308f * x * (1.0f + 0.044715f * x * x)); }
__device__ __forceinline__ void st4bf(bf16_t* p, f32x4 v) { u32x2 w; w.x = cvt_pk_bf16(v[0], v[1]); w.y = cvt_pk_bf16(v[2], v[3]); *(u32x2*)p = w; }
__device__ __forceinline__ f32x4 ld4bf(const bf16_t* p) { const u32x2 w = *(const u32x2*)p; f32x4 v; v[0] = __uint_as_float(w.x << 16); v[1] = __uint_as_float(w.x & 0xffff0000u); v[2] = __uint_as_float(w.y << 16); v[3] = __uint_as_float(w.y & 0xffff0000u); return v; }

struct EpiSwiGLU {
    static constexpr bool PERM = true, AFTER_DRAIN = false;
    bf16_t* O; int ldc;
    __device__ __forceinline__ void operator()(const f32x4 (&acc)[2][2][4][2], const Unit& u, int wr, int wc, int fr, int fq) const {
        const int row0 = u.pm * BM + wr * 64 + fr, col0 = u.pn * HALF + wc * 32 + 8 * fq;
#pragma unroll
        for (int ai = 0; ai < 2; ++ai)
#pragma unroll
            for (int m = 0; m < 4; ++m) {
                bf16_t* p = O + (size_t)(row0 + ai * HALF + m * 16) * ldc + col0;
                const f32x4 g0 = acc[ai][0][m][0], g1 = acc[ai][0][m][1], u0 = acc[ai][1][m][0], u1 = acc[ai][1][m][1];
                float v[8];
#pragma unroll
                for (int i = 0; i < 4; ++i) { v[i] = g0[i] * sigm(g0[i]) * u0[i]; v[4 + i] = g1[i] * sigm(g1[i]) * u1[i]; }
                u32x4 w; w.x = cvt_pk_bf16(v[0], v[1]); w.y = cvt_pk_bf16(v[2], v[3]); w.z = cvt_pk_bf16(v[4], v[5]); w.w = cvt_pk_bf16(v[6], v[7]);
                *(u32x4*)p = w;
            }
    }
};
struct EpiF32 {
    static constexpr bool PERM = false, AFTER_DRAIN = false;
    float* C; int ldc;
    __device__ __forceinline__ void operator()(const f32x4 (&acc)[2][2][4][2], const Unit& u, int wr, int wc, int fr, int fq) const {
        const int row0 = u.pm * BM + wr * 64 + fr, col0 = u.pn * BM + wc * 32 + 4 * fq;
#pragma unroll
        for (int ai = 0; ai < 2; ++ai)
#pragma unroll
            for (int m = 0; m < 4; ++m) { float* rowp = C + (size_t)(row0 + ai * HALF + m * 16) * ldc + col0;
#pragma unroll
                for (int bj = 0; bj < 2; ++bj)
#pragma unroll
                    for (int n = 0; n < 2; ++n) *(f32x4*)(rowp + bj * HALF + n * 16) = acc[ai][bj][m][n]; }
    }
};
struct EpiWin {
    static constexpr bool PERM = false, AFTER_DRAIN = false;
    bf16_t *XR, *GR, *Q, *KB, *VB, *GM; float *ock, *ocv; const float *rc, *rs;
    __device__ __forceinline__ void operator()(const f32x4 (&acc)[2][2][4][2], const Unit& u, int wr, int wc, int fr, int fq) const {
        const int pn = u.pn, rl0 = wr * 64 + fr, c0 = wc * 32 + 4 * fq;
        const bool samp = u.pm >= 32;
        if (pn < 16 || pn >= 28) {
            bf16_t* base; int ld; int mode;
            if (pn < 8) { base = XR + pn * BM; ld = 2048; mode = 0; }
            else if (pn < 16) { base = GR + (pn - 8) * BM; ld = 2048; mode = 1; }
            else { base = GM + (pn - 28) * BM; ld = 4096; mode = 2; }
            base += (size_t)(u.pm * BM + rl0) * ld + c0;
            if (mode == 0) {
#pragma unroll
                for (int ai = 0; ai < 2; ++ai)
#pragma unroll
                    for (int m = 0; m < 4; ++m) { bf16_t* rowp = base + (size_t)(ai * HALF + m * 16) * ld;
#pragma unroll
                        for (int bj = 0; bj < 2; ++bj)
#pragma unroll
                            for (int n = 0; n < 2; ++n) st4bf(rowp + bj * HALF + n * 16, acc[ai][bj][m][n]); }
            } else if (mode == 1) {
#pragma unroll
                for (int ai = 0; ai < 2; ++ai)
#pragma unroll
                    for (int m = 0; m < 4; ++m) { bf16_t* rowp = base + (size_t)(ai * HALF + m * 16) * ld;
#pragma unroll
                        for (int bj = 0; bj < 2; ++bj)
#pragma unroll
                            for (int n = 0; n < 2; ++n) { f32x4 v = acc[ai][bj][m][n];
#pragma unroll
                                for (int i = 0; i < 4; ++i) v[i] = gelu_tanh(v[i]);
                                st4bf(rowp + bj * HALF + n * 16, v); } }
            } else {
#pragma unroll
                for (int ai = 0; ai < 2; ++ai)
#pragma unroll
                    for (int m = 0; m < 4; ++m) { bf16_t* rowp = base + (size_t)(ai * HALF + m * 16) * ld;
#pragma unroll
                        for (int bj = 0; bj < 2; ++bj)
#pragma unroll
                            for (int n = 0; n < 2; ++n) { f32x4 v = acc[ai][bj][m][n];
#pragma unroll
                                for (int i = 0; i < 4; ++i) v[i] = sigm(v[i]);
                                st4bf(rowp + bj * HALF + n * 16, v); } }
            }
            return;
        }
        int b, t0, kvrow0;
        if (samp) { const int ms0 = (u.pm - 32) * BM; b = ms0 >> 11; t0 = ms0 & 2047; kvrow0 = 8192 + b * 2560 + 512 + t0; }
        else { b = u.pm; t0 = 0; kvrow0 = u.pm * BM; }
        if (pn < 24) {
            const bool isk = pn >= 20; const int cb = (isk ? pn - 20 : pn - 16) * BM + c0;
            bf16_t* dst = isk ? KB + (size_t)(kvrow0 + rl0) * 1024 + cb : Q + (size_t)(u.pm * BM + rl0) * 1024 + cb;
            if (samp) {
                const int axis = wc & 1;
#pragma unroll
                for (int ai = 0; ai < 2; ++ai)
#pragma unroll
                    for (int m = 0; m < 4; ++m) { const int t = t0 + rl0 + ai * HALF + m * 16; const int pos = axis ? (t & 63) : (t >> 6);
                        const f32x4 c4 = *(const f32x4*)(rc + pos * 16 + 4 * fq), s4 = *(const f32x4*)(rs + pos * 16 + 4 * fq);
                        bf16_t* rowp = dst + (size_t)(ai * HALF + m * 16) * 1024;
#pragma unroll
                        for (int bj = 0; bj < 2; ++bj) { const f32x4 x1 = acc[ai][bj][m][0], x2 = acc[ai][bj][m][1];
                            st4bf(rowp + bj * HALF, x1 * c4 - x2 * s4); st4bf(rowp + bj * HALF + 16, x2 * c4 + x1 * s4); }
                        asm volatile("" ::: "memory"); }
            } else {
                float* oc = isk ? ock + ((size_t)b * 512 + rl0) * 1024 + cb : nullptr;
#pragma unroll
                for (int ai = 0; ai < 2; ++ai)
#pragma unroll
                    for (int m = 0; m < 4; ++m) { bf16_t* rowp = dst + (size_t)(ai * HALF + m * 16) * 1024;
#pragma unroll
                        for (int bj = 0; bj < 2; ++bj)
#pragma unroll
                            for (int n = 0; n < 2; ++n) { st4bf(rowp + bj * HALF + n * 16, acc[ai][bj][m][n]);
                                if (isk) *(f32x4*)(oc + (size_t)(ai * HALF + m * 16) * 1024 + bj * HALF + n * 16) = acc[ai][bj][m][n]; } }
            }
        } else {
            const int cb = (pn - 24) * BM + c0;
            bf16_t* dst = VB + (size_t)(kvrow0 + rl0) * 1024 + cb;
            float* oc = ocv + ((size_t)b * 512 + rl0) * 1024 + cb;
#pragma unroll
            for (int ai = 0; ai < 2; ++ai)
#pragma unroll
                for (int m = 0; m < 4; ++m) { bf16_t* rowp = dst + (size_t)(ai * HALF + m * 16) * 1024;
#pragma unroll
                    for (int bj = 0; bj < 2; ++bj)
#pragma unroll
                        for (int n = 0; n < 2; ++n) { st4bf(rowp + bj * HALF + n * 16, acc[ai][bj][m][n]);
                            if (!samp) *(f32x4*)(oc + (size_t)(ai * HALF + m * 16) * 1024 + bj * HALF + n * 16) = acc[ai][bj][m][n]; } }
        }
    }
};
struct EpiGate1 {
    static constexpr bool PERM = false, AFTER_DRAIN = false;
    float* U32; const bf16_t* GM;
    __device__ __forceinline__ void operator()(const f32x4 (&acc)[2][2][4][2], const Unit& u, int wr, int wc, int fr, int fq) const {
        const int row0 = u.pm * BM + wr * 64 + fr, col0 = u.pn * BM + wc * 32 + 4 * fq;
#pragma unroll
        for (int ai = 0; ai < 2; ++ai)
#pragma unroll
            for (int m = 0; m < 4; ++m) { const size_t r = (size_t)(row0 + ai * HALF + m * 16);
#pragma unroll
                for (int bj = 0; bj < 2; ++bj)
#pragma unroll
                    for (int n = 0; n < 2; ++n) { const int c = col0 + bj * HALF + n * 16;
                        *(f32x4*)(U32 + r * 2048 + c) = ld4bf(GM + r * 4096 + c) * acc[ai][bj][m][n]; }
                asm volatile("" ::: "memory"); }
    }
};
struct EpiGate2 {
    static constexpr bool PERM = false, AFTER_DRAIN = false;
    const float* U32; const bf16_t* GM; bf16_t* U;
    __device__ __forceinline__ void operator()(const f32x4 (&acc)[2][2][4][2], const Unit& u, int wr, int wc, int fr, int fq) const {
        const int row0 = u.pm * BM + wr * 64 + fr, col0 = u.pn * BM + wc * 32 + 4 * fq;
#pragma unroll
        for (int ai = 0; ai < 2; ++ai)
#pragma unroll
            for (int m = 0; m < 4; ++m) { const size_t r = (size_t)(row0 + ai * HALF + m * 16);
#pragma unroll
                for (int bj = 0; bj < 2; ++bj)
#pragma unroll
                    for (int n = 0; n < 2; ++n) { const int c = col0 + bj * HALF + n * 16;
                        const f32x4 v = *(const f32x4*)(U32 + r * 2048 + c) + ld4bf(GM + r * 4096 + 2048 + c) * acc[ai][bj][m][n];
                        st4bf(U + r * 2048 + c, v); }
                asm volatile("" ::: "memory"); }
    }
};
template <class Epi, class Sched, bool ALIGN_EPI = false, bool SP2 = false>
__device__ __forceinline__ void gemm_phase(PG8_LAS unsigned char* lds, const Gemm g, const Sched& S, const Epi& E) {
    const int tid = opaque_tid(), wid = __builtin_amdgcn_readfirstlane(tid >> 6), lane = tid & 63, wr = wid >> 2, wc = wid & 3, fr = lane & 15, fq = lane >> 4;
    const int K = g.K, nt = K / BK;
    unsigned voffA[2], voffB[2];
#pragma unroll
    for (int i = 0; i < 2; ++i) { int R, C; stage_rc(tid * 16 + i * 8192, R, C); const int Rb = Epi::PERM ? ((R & ~31) + perm32(R & 31)) : R;
        voffA[i] = (unsigned)(R * K + C) * 2u; voffB[i] = (unsigned)(Rb * K + C) * 2u; }
    const size_t kstep = (size_t)(BK * 2);
    const size_t hstep = (size_t)HALF * K * 2;
    const size_t tstep = 2 * hstep;
    const unsigned ldsw = (unsigned)wid * 1024u;
    const int aoff = lds_byte(wr * 64 + fr, fq * 8), boff = lds_byte(wc * 32 + fr, fq * 8);
#define PG8_SA(b, h) (((b) * 2 + (h)) * HTB)
#define PG8_SB(b, h) ((4 + (b) * 2 + (h)) * HTB)
#define PG8_STAGE(bufoff, gbase, voff) do { _Pragma("unroll") for (int _i = 0; _i < 2; ++_i) \
        __builtin_amdgcn_global_load_lds((const unsigned*)((const char*)(gbase) + (voff)[_i]), (PG8_LAS unsigned*)(lds + (bufoff) + ldsw + _i * 8192), 16, 0, 0); } while (0)
#define PG8_LDA(dst, b, h) do { _Pragma("unroll") for (int m = 0; m < 4; ++m) _Pragma("unroll") for (int k = 0; k < 2; ++k) dst[m][k] = *(const PG8_LAS bf16x8*)(lds + PG8_SA(b, h) + aoff + m * 2048 + k * 1024); } while (0)
#define PG8_LDB(dst, b, h) do { _Pragma("unroll") for (int n = 0; n < 2; ++n) _Pragma("unroll") for (int k = 0; k < 2; ++k) dst[n][k] = *(const PG8_LAS bf16x8*)(lds + PG8_SB(b, h) + boff + n * 2048 + k * 1024); } while (0)
#define PG8_MMA(ai, bj, At, Bt) do { __builtin_amdgcn_s_setprio(1); _Pragma("unroll") for (int m = 0; m < 4; ++m) _Pragma("unroll") for (int n = 0; n < 2; ++n) _Pragma("unroll") for (int k = 0; k < 2; ++k) \
        acc[ai][bj][m][n] = __builtin_amdgcn_mfma_f32_16x16x32_bf16(Bt[n][k], At[m][k], acc[ai][bj][m][n], 0, 0, 0); __builtin_amdgcn_s_setprio(0); } while (0)
#define PG8_WAIT_V(n) asm volatile("s_waitcnt vmcnt(" #n ")" ::: "memory")
#define PG8_WAIT_L(n) asm volatile("s_waitcnt lgkmcnt(" #n ")" ::: "memory")
#define PG8_BAR __builtin_amdgcn_s_barrier()
#define PG8_SCHED __builtin_amdgcn_sched_barrier(0)
    Unit cur, nxt; int ui = 0;
    if (!S.next(0, cur)) return;
    f32x4 acc[2][2][4][2];
#pragma unroll
    for (int a = 0; a < 2; ++a)
#pragma unroll
        for (int b = 0; b < 2; ++b)
#pragma unroll
            for (int m = 0; m < 4; ++m)
#pragma unroll
                for (int n = 0; n < 2; ++n) acc[a][b][m][n] = (f32x4){0.f, 0.f, 0.f, 0.f};
    bf16x8 At[4][2], B0[2][2], B1[2][2];
    const char* cA = (const char*)g.A + (size_t)cur.pm * tstep; const char* cB = (const char*)g.Bt + (size_t)cur.pn * tstep;
    S.a_ready(cur);
    if constexpr (SP2) {
        PG8_STAGE(PG8_SB(0, 0), cB, voffB); PG8_STAGE(PG8_SB(0, 1), cB + hstep, voffB); PG8_STAGE(PG8_SA(0, 0), cA, voffA); PG8_STAGE(PG8_SA(0, 1), cA + hstep, voffA);
        if (wr == 1) PG8_BAR;
        PG8_WAIT_V(2); PG8_BAR;
        PG8_STAGE(PG8_SB(1, 0), cB + kstep, voffB); PG8_STAGE(PG8_SA(1, 0), cA + kstep, voffA); PG8_STAGE(PG8_SB(1, 1), cB + hstep + kstep, voffB);
        PG8_WAIT_V(6); PG8_BAR;
    } else {
        PG8_STAGE(PG8_SB(0, 0), cB, voffB); PG8_STAGE(PG8_SA(0, 0), cA, voffA); PG8_STAGE(PG8_SB(0, 1), cB + hstep, voffB); PG8_STAGE(PG8_SA(0, 1), cA + hstep, voffA);
        if (wr == 1) PG8_BAR;
        PG8_WAIT_V(4); PG8_BAR;
        PG8_STAGE(PG8_SB(1, 0), cB + kstep, voffB); PG8_STAGE(PG8_SA(1, 0), cA + kstep, voffA); PG8_STAGE(PG8_SB(1, 1), cB + hstep + kstep, voffB);
        PG8_WAIT_V(6); PG8_BAR;
    }
    for (;;) {
        const bool has_next = S.next(ui + 1, nxt);
        const char* nA = has_next ? (const char*)g.A + (size_t)nxt.pm * tstep : cA; const char* nB = has_next ? (const char*)g.Bt + (size_t)nxt.pn * tstep : cB;
        for (int t = 0; t < nt; t += 2) {
            const bool last = (t == nt - 2);
            const char* a1 = cA + (size_t)(t + 1) * kstep;
            const char* a2 = last ? nA : cA + (size_t)(t + 2) * kstep; const char* b2 = last ? nB : cB + (size_t)(t + 2) * kstep;
            const char* a3 = a2 + kstep; const char* b3 = b2 + kstep;
            if (last && has_next) S.a_ready(nxt);
            if constexpr (SP2) {
            PG8_LDB(B0, 0, 0); PG8_LDB(B1, 0, 1); PG8_SCHED; PG8_LDA(At, 0, 0); PG8_STAGE(PG8_SA(1, 1), a1 + hstep, voffA);
            PG8_WAIT_V(8); PG8_WAIT_L(0); PG8_BAR; PG8_MMA(0, 0, At, B0); PG8_MMA(0, 1, At, B1); PG8_BAR; PG8_SCHED;
            PG8_LDA(At, 0, 1); PG8_STAGE(PG8_SB(0, 0), b2, voffB); PG8_STAGE(PG8_SB(0, 1), b2 + hstep, voffB); PG8_STAGE(PG8_SA(0, 0), a2, voffA);
            PG8_WAIT_V(8); PG8_WAIT_L(0); PG8_BAR; PG8_MMA(1, 0, At, B0); PG8_MMA(1, 1, At, B1); PG8_BAR; PG8_SCHED;
            PG8_LDB(B0, 1, 0); PG8_LDB(B1, 1, 1); PG8_SCHED; PG8_LDA(At, 1, 0); PG8_STAGE(PG8_SA(0, 1), a2 + hstep, voffA);
            PG8_WAIT_V(8); PG8_WAIT_L(0); PG8_BAR; PG8_MMA(0, 0, At, B0); PG8_MMA(0, 1, At, B1); PG8_BAR; PG8_SCHED;
            PG8_LDA(At, 1, 1); PG8_STAGE(PG8_SB(1, 0), b3, voffB); PG8_STAGE(PG8_SB(1, 1), b3 + hstep, voffB); PG8_STAGE(PG8_SA(1, 0), a3, voffA);
            PG8_WAIT_V(8); PG8_WAIT_L(0); PG8_BAR; PG8_MMA(1, 0, At, B0); PG8_MMA(1, 1, At, B1); PG8_BAR; PG8_SCHED;
            } else {
            PG8_LDB(B0, 0, 0); PG8_SCHED; PG8_LDA(At, 0, 0); PG8_STAGE(PG8_SA(1, 1), a1 + hstep, voffA);
            PG8_WAIT_L(8); PG8_BAR; PG8_WAIT_L(0); PG8_MMA(0, 0, At, B0); PG8_BAR; PG8_SCHED;
            PG8_LDB(B1, 0, 1); PG8_STAGE(PG8_SB(0, 0), b2, voffB);
            PG8_BAR; PG8_WAIT_L(0); PG8_MMA(0, 1, At, B1); PG8_BAR;
            PG8_LDA(At, 0, 1); PG8_STAGE(PG8_SA(0, 0), a2, voffA);
            PG8_BAR; PG8_WAIT_L(0); PG8_MMA(1, 0, At, B0); PG8_BAR; PG8_SCHED;
            PG8_STAGE(PG8_SB(0, 1), b2 + hstep, voffB);
            PG8_WAIT_V(6); PG8_BAR; PG8_MMA(1, 1, At, B1); PG8_BAR;
            PG8_LDB(B0, 1, 0); PG8_SCHED; PG8_LDA(At, 1, 0); PG8_STAGE(PG8_SA(0, 1), a2 + hstep, voffA);
            PG8_WAIT_L(8); PG8_BAR; PG8_WAIT_L(0); PG8_MMA(0, 0, At, B0); PG8_BAR; PG8_SCHED;
            PG8_LDB(B1, 1, 1); PG8_STAGE(PG8_SB(1, 0), b3, voffB);
            PG8_BAR; PG8_WAIT_L(0); PG8_MMA(0, 1, At, B1); PG8_BAR;
            PG8_LDA(At, 1, 1); PG8_STAGE(PG8_SA(1, 0), a3, voffA);
            PG8_BAR; PG8_WAIT_L(0); PG8_MMA(1, 0, At, B0); PG8_BAR; PG8_SCHED;
            PG8_STAGE(PG8_SB(1, 1), b3 + hstep, voffB);
            PG8_WAIT_V(6); PG8_BAR; PG8_MMA(1, 1, At, B1); PG8_BAR;
            }
        }
        if constexpr (ALIGN_EPI) { if (wr == 0) PG8_BAR; }
        if constexpr (!Epi::AFTER_DRAIN) { E(acc, cur, wr, wc, fr, fq); S.done(cur); }
        if (!has_next) break;
#pragma unroll
        for (int a = 0; a < 2; ++a)
#pragma unroll
            for (int b = 0; b < 2; ++b)
#pragma unroll
                for (int m = 0; m < 4; ++m)
#pragma unroll
                    for (int n = 0; n < 2; ++n) acc[a][b][m][n] = (f32x4){0.f, 0.f, 0.f, 0.f};
        cur = nxt; cA = nA; cB = nB; ++ui;
        if constexpr (ALIGN_EPI) { if (wr == 1) PG8_BAR; }
    }
    PG8_WAIT_V(0);
    if constexpr (!ALIGN_EPI) { if (wr == 0) PG8_BAR; }
    PG8_BAR;
    if constexpr (Epi::AFTER_DRAIN) { E.fused(acc, cur, wr, wc, fr, fq, lds, wid, lane); S.done(cur); }
#undef PG8_SA
#undef PG8_SB
#undef PG8_STAGE
#undef PG8_LDA
#undef PG8_LDB
#undef PG8_MMA
#undef PG8_WAIT_V
#undef PG8_WAIT_L
#undef PG8_BAR
#undef PG8_SCHED
}
}
#define GAS __attribute__((address_space(1)))
#define LAS __attribute__((address_space(3)))
typedef unsigned short bf16;
typedef unsigned v4u __attribute__((ext_vector_type(4)));
typedef float f32x4 __attribute__((ext_vector_type(4)));
typedef short bf16x8 __attribute__((ext_vector_type(8)));
typedef GAS unsigned gu32;
typedef GAS unsigned long long gu64;
#define RLX_AGENT __ATOMIC_RELAXED, __HIP_MEMORY_SCOPE_AGENT
#define LDS_WAIT() asm volatile("s_waitcnt lgkmcnt(0)" ::: "memory")
#define VM_WAIT() asm volatile("s_waitcnt vmcnt(0)" ::: "memory")
__device__ __forceinline__ unsigned long long rt() { return __builtin_amdgcn_s_memrealtime(); }
__device__ __forceinline__ unsigned f2bf(float f) { unsigned u = __builtin_bit_cast(unsigned, f); return (u + 0x7fffu + ((u >> 16) & 1u)) >> 16; }
__device__ __forceinline__ unsigned pk2(float lo, float hi) { return f2bf(lo) | (f2bf(hi) << 16); }
#define XB_TMO      128
#define XB_XCNT(j)  (256  + 64 * (j))
#define XB_XSUB(j)  (1280 + 64 * (j))
#define XB_XGEN(j)  (2304 + 64 * (j))
#define XB_TOP      3328
#define XB_TOPGEN   3392
#define XCD_BAR_WORDS 3456
#define XB_SPIN_CAP (1u << 18)

__device__ __forceinline__ unsigned xb_ld(unsigned* p)              { return __hip_atomic_load(p, __ATOMIC_RELAXED, __HIP_MEMORY_SCOPE_AGENT); }
__device__ __forceinline__ unsigned xb_add(unsigned* p, unsigned v) { return __hip_atomic_fetch_add(p, v, __ATOMIC_RELAXED, __HIP_MEMORY_SCOPE_AGENT); }
__device__ __forceinline__ unsigned xb_xcc_id() { return (unsigned)__builtin_amdgcn_s_getreg((3 << 11) | 20) & 0xFu; }
#define XB_SPIN(cond, bar) do { unsigned _sp = 0; while (cond) { __builtin_amdgcn_s_sleep(1); \
    if ((++_sp & 255u) == 0u) { if (xb_ld(&(bar)[XB_TMO])) break; if (_sp > XB_SPIN_CAP) { atomicAdd(&(bar)[XB_TMO], 1u); break; } } } } while (0)

struct XcdBarrier {
    unsigned* bar; unsigned x;
    volatile LAS unsigned* st;
};

__device__ __forceinline__ XcdBarrier xcd_barrier_post(unsigned* bar, volatile LAS unsigned* st) {
    XcdBarrier b; b.bar = bar; b.x = xb_xcc_id(); b.st = st;
    if (threadIdx.x == 0) (void)xb_add(&bar[XB_XCNT(b.x)], 1u);
    return b;
}
__device__ __forceinline__ void xcd_barrier_complete(unsigned* bar, unsigned x, unsigned& nloc, unsigned& nx) {
    const unsigned G = gridDim.x * gridDim.y * gridDim.z;
    unsigned sum, cnt, mine, sp = 0u;
    for (;;) {
        sum = 0u; cnt = 0u; mine = 0u;
#pragma unroll
        for (unsigned j = 0; j < 16; ++j) { const unsigned c = xb_ld(&bar[XB_XCNT(j)]); sum += c; cnt += (c > 0u) ? 1u : 0u; mine = (j == x) ? c : mine; }
        if (sum == G) break;
        __builtin_amdgcn_s_sleep(1);
        if ((++sp & 255u) == 0u) { if (xb_ld(&bar[XB_TMO])) break; if (sp > XB_SPIN_CAP) { atomicAdd(&bar[XB_TMO], 1u); break; } }
    }
    nloc = mine > 0u ? mine : 1u; nx = cnt > 0u ? cnt : 1u;
}

__device__ __forceinline__ void xcd_barrier(const XcdBarrier& b) {
    asm volatile("s_waitcnt vmcnt(0)" ::: "memory");
    __syncthreads();
    if (threadIdx.x == 0) {
        unsigned* bar = b.bar;
        __builtin_amdgcn_s_waitcnt(0);
        unsigned nloc = b.st[0], nx = b.st[1];
        if (nloc == 0u) { xcd_barrier_complete(bar, b.x, nloc, nx); b.st[0] = nloc; b.st[1] = nx; }
        const unsigned old = xb_add(&bar[XB_XSUB(b.x)], 1u);
        const unsigned gen = old / nloc;
        if (old + 1u == (gen + 1u) * nloc) {
            __builtin_amdgcn_fence(__ATOMIC_RELEASE, "agent");
            asm volatile("s_waitcnt vmcnt(0)" ::: "memory");
            const unsigned og = xb_add(&bar[XB_TOP], 1u);
            const unsigned tg = og / nx;
            if (og + 1u == (tg + 1u) * nx) xb_add(&bar[XB_TOPGEN], 1u);
            else XB_SPIN(xb_ld(&bar[XB_TOPGEN]) == tg, bar);
            __builtin_amdgcn_fence(__ATOMIC_ACQUIRE, "agent");
            xb_add(&bar[XB_XGEN(b.x)], 1u);
            asm volatile("s_waitcnt vmcnt(0)" ::: "memory");
        } else {
            XB_SPIN(xb_ld(&bar[XB_XGEN(b.x)]) == gen, bar);
            __builtin_amdgcn_fence(__ATOMIC_ACQUIRE, "agent");
            asm volatile("s_waitcnt vmcnt(0)" ::: "memory");
        }
    }
    __syncthreads();
}

constexpr int DM = 2048, DFF = 5504, NFF2 = 11008, NIN = 11264, NMODC = 18432;
constexpr int MC = 8192, MS = 16384, M = 24576, TCX = 256, TSM = 2048, PAST = 512, KVS = 2560;
constexpr int KVROWS = MC + 8 * KVS;
constexpr float NORM_EPS = 1e-6f;
constexpr int NPHASE = 27;
constexpr int NWAVES = 8;

constexpr size_t MiB = 1u << 20;
constexpr size_t WS_CTL = 0, CTL_ZERO_BYTES = 1 * MiB;
constexpr size_t WS_MODP = 1 * MiB;
constexpr size_t WS_MOD = 22 * MiB;
constexpr size_t WS_ROPE = 24 * MiB;
constexpr size_t WS_W1T = 25 * MiB;
constexpr size_t WS_W2T = 111 * MiB;
constexpr size_t WS_WINT = 154 * MiB;
constexpr size_t WS_PLRUT = 198 * MiB;
constexpr size_t WS_PATTNT = 206 * MiB;
constexpr size_t WS_WOUTT = 210 * MiB;
constexpr size_t WS_WG = 218 * MiB;
constexpr size_t WS_KB = 220 * MiB;
constexpr size_t WS_VB = 276 * MiB;
constexpr size_t WS_H = 332 * MiB;
constexpr size_t WS_R1 = 428 * MiB;
constexpr size_t WS_R2 = 686 * MiB;
constexpr size_t WS_GM = 878 * MiB;
constexpr size_t WS_HF = 1070 * MiB;
constexpr size_t WS_HB = 1166 * MiB;
constexpr size_t WS_END = 1262 * MiB;
constexpr int CW_BAR = 4096;

constexpr int RING_BYTES = 131072;
constexpr int LDSCTL_OFF = RING_BYTES, MISC_OFF = LDSCTL_OFF + 320;
constexpr int LDS_BYTES = 147456;
constexpr int PTAB_OFF = LDSCTL_OFF + 1024;

__device__ __forceinline__ float wave_sum(float v) {
#pragma unroll
    for (int o = 1; o < 64; o <<= 1) v += __shfl_xor(v, o);
    return v;
}
__device__ __forceinline__ unsigned cvtpk(float lo, float hi) { unsigned r; asm volatile("v_cvt_pk_bf16_f32 %0, %1, %2" : "=v"(r) : "v"(lo), "v"(hi)); return r; }
__device__ __forceinline__ float bflo(unsigned w) { return __uint_as_float(w << 16); }
__device__ __forceinline__ float bfhi(unsigned w) { return __uint_as_float(w & 0xffff0000u); }

__device__ __forceinline__ void transpose_item(const float* __restrict__ W, int N, int k0, int n0, bf16* __restrict__ WT, int K, int drow0, LAS float* scr, int lane) {
#pragma unroll 8
    for (int i = 0; i < 32; ++i) { const int kk = 2 * i + (lane >> 5); scr[kk * 33 + (lane & 31)] = W[(size_t)(k0 + kk) * N + n0 + (lane & 31)]; }
    LDS_WAIT(); asm volatile("" ::: "memory");
    const int c = lane & 7;
#pragma unroll
    for (int j = 0; j < 4; ++j) { const int n = (lane >> 3) + 8 * j; const LAS float* s = scr + (8 * c) * 33 + n;
        v4u o; o.x = cvtpk(s[0 * 33], s[1 * 33]); o.y = cvtpk(s[2 * 33], s[3 * 33]); o.z = cvtpk(s[4 * 33], s[5 * 33]); o.w = cvtpk(s[6 * 33], s[7 * 33]);
        *(GAS v4u*)(WT + (size_t)(drow0 + n) * K + k0 + 8 * c) = o; }
    LDS_WAIT(); asm volatile("" ::: "memory");
}
struct Ptrs {
    const volatile LAS unsigned* tab; float* out; unsigned char* ws;
    __device__ __forceinline__ const float* in(int i) const { const unsigned lo = (unsigned)__builtin_amdgcn_readfirstlane((int)tab[2 * i]), hi = (unsigned)__builtin_amdgcn_readfirstlane((int)tab[2 * i + 1]);
        return (const float*)(const GAS float*)(((unsigned long long)hi << 32) | lo); }
};
__device__ __forceinline__ void convert_weights(const Ptrs& P, int l, LAS unsigned char* lds, int gw, int NGW, int wave, int lane) {
    LAS float* scr = (LAS float*)(lds + wave * 16384);
    bf16* W1T = (bf16*)(P.ws + WS_W1T); bf16* W2T = (bf16*)(P.ws + WS_W2T); bf16* WINT = (bf16*)(P.ws + WS_WINT);
    bf16* PLT = (bf16*)(P.ws + WS_PLRUT); bf16* PAT = (bf16*)(P.ws + WS_PATTNT); bf16* WOT = (bf16*)(P.ws + WS_WOUTT); bf16* WG = (bf16*)(P.ws + WS_WG);
    constexpr int I_W1 = 2 * 32 * 344, I_W2 = 2 * 86 * 64, I_WIN = 32 * 352, I_PL = 32 * 64, I_PA = 16 * 64, I_WO = 32 * 64, I_G = 512;
    constexpr int NIT = I_W1 + I_W2 + I_WIN + I_PL + I_PA + I_WO + I_G;
    for (int it = gw; it < NIT; it += NGW) {
        int r = it;
        if (r < I_W1) { const int f = r / 11008, r2 = r % 11008, kb = r2 / 344, nb = r2 % 344, n0 = 32 * nb, isu = n0 / DFF, j0 = n0 % DFF;
            transpose_item(P.in(11) + (size_t)(l * 2 + f) * DM * NFF2, NFF2, 64 * kb, n0, W1T + (size_t)f * NFF2 * DM, DM, (j0 >> 7) * 256 + isu * 128 + (j0 & 127), scr, lane); continue; }
        r -= I_W1;
        if (r < I_W2) { const int f = r / 5504, r2 = r % 5504, kb = r2 / 64, nb = r2 % 64;
            transpose_item(P.in(12) + (size_t)(l * 2 + f) * DFF * DM, DM, 64 * kb, 32 * nb, W2T + (size_t)f * DM * DFF, DFF, 32 * nb, scr, lane); continue; }
        r -= I_W2;
        if (r < I_WIN) { const int kb = r / 352, nb = r % 352;
            transpose_item(P.in(13) + (size_t)l * DM * NIN, NIN, 64 * kb, 32 * nb, WINT, DM, 32 * nb, scr, lane); continue; }
        r -= I_WIN;
        if (r < I_PL) { const int kb = r / 64, nb = r % 64;
            transpose_item(P.in(26) + (size_t)l * DM * DM, DM, 64 * kb, 32 * nb, PLT, DM, 32 * nb, scr, lane); continue; }
        r -= I_PL;
        if (r < I_PA) { const int kb = r / 64, nb = r % 64;
            transpose_item(P.in(27) + (size_t)l * 1024 * DM, DM, 64 * kb, 32 * nb, PAT, 1024, 32 * nb, scr, lane); continue; }
        r -= I_PA;
        if (r < I_WO) { const int kb = r / 64, nb = r % 64;
            transpose_item(P.in(28) + (size_t)l * DM * DM, DM, 64 * kb, 32 * nb, WOT, DM, 32 * nb, scr, lane); continue; }
        r -= I_WO;
        { const int mat = r >> 7, g = mat >> 1, dir = mat & 1, r2 = r & 127, n = r2 >> 3, r3 = r2 & 7, kb = r3 >> 2, nb = r3 & 3;
          const float* src = (g ? P.in(18) : P.in(16)) + (size_t)((l * 2 + dir) * 16 + n) * 16384;
          transpose_item(src, 128, 64 * kb, 32 * nb, WG + (size_t)((n * 2 + dir) * 2 + g) * 16384, 128, 32 * nb, scr, lane); }
    }
}
__device__ __forceinline__ void mod_partials(const Ptrs& P, LAS unsigned char* lds, int gw, int NGW, int wave, int lane) {
    LAS float* scr = (LAS float*)(lds + wave * 16384);
    float* modp = (float*)(P.ws + WS_MODP);
    const float* cvec = P.in(2); const float* cctx = P.in(6); const float* wmod = P.in(7);
    for (int it = gw; it < 2 * 72 * 16; it += NGW) {
        const int kc = it & 15, rest = it >> 4, nb = rest % 72, l = rest / 72, k0 = kc * 128;
        for (int idx = lane; idx < 128 * 9; idx += 64) { const int k = idx / 9, r = idx - 9 * k;
            const float x = (r == 0) ? cctx[k0 + k] : cvec[(r - 1) * DM + k0 + k]; scr[k * 12 + r] = x / (1.0f + expf(-x)); }
        LDS_WAIT(); asm volatile("" ::: "memory");
        const GAS f32x4* wp = (const GAS f32x4*)(wmod + ((size_t)l * DM + k0) * NMODC + nb * 256) + lane;
        f32x4 acc[9];
#pragma unroll
        for (int r = 0; r < 9; ++r) acc[r] = (f32x4){0.f, 0.f, 0.f, 0.f};
#pragma unroll 4
        for (int k = 0; k < 128; ++k) {
            const f32x4 w = wp[(size_t)k * (NMODC / 4)];
            const f32x4 s0 = *(const LAS f32x4*)(scr + k * 12), s1 = *(const LAS f32x4*)(scr + k * 12 + 4); const float s2 = scr[k * 12 + 8];
            acc[0] += w * s0[0]; acc[1] += w * s0[1]; acc[2] += w * s0[2]; acc[3] += w * s0[3];
            acc[4] += w * s1[0]; acc[5] += w * s1[1]; acc[6] += w * s1[2]; acc[7] += w * s1[3]; acc[8] += w * s2;
        }
#pragma unroll
        for (int r = 0; r < 9; ++r) *(GAS f32x4*)(modp + ((size_t)(kc * 2 + l) * 9 + r) * NMODC + nb * 256 + 4 * lane) = acc[r];
        LDS_WAIT(); asm volatile("" ::: "memory");
    }
}
__device__ __forceinline__ void mod_reduce(const Ptrs& P, int gtid, int NT) {
    const float* modp = (const float*)(P.ws + WS_MODP); float* mod = (float*)(P.ws + WS_MOD); const float* bmod = P.in(8);
    for (int i = gtid; i < 2 * 9 * (NMODC / 4); i += NT) {
        const int n4 = i % (NMODC / 4), lr = i / (NMODC / 4), l = lr / 9;
        f32x4 s = *(const GAS f32x4*)(bmod + (size_t)l * NMODC + 4 * n4);
#pragma unroll
        for (int kc = 0; kc < 16; ++kc) s += *(const GAS f32x4*)(modp + ((size_t)kc * 18 + lr) * NMODC + 4 * n4);
        *(GAS f32x4*)(mod + (size_t)lr * NMODC + 4 * n4) = s;
    }
}
__device__ __forceinline__ void convert_cache(const Ptrs& P, int l, int gtid, int NT) {
    bf16* KB = (bf16*)(P.ws + WS_KB); bf16* VB = (bf16*)(P.ws + WS_VB);
    for (int i = gtid; i < 2 * 4096 * 128; i += NT) {
        const int tens = i >> 19, j = i & ((1 << 19) - 1), row = j >> 7, ch = j & 127, b = row >> 9, p = row & 511;
        const float* src = (tens ? P.in(4) : P.in(3)) + ((size_t)(b * 2 + l) * 512 + p) * 1024 + ch * 8;
        bf16* dst = (tens ? VB : KB) + (size_t)(MC + b * KVS + p) * 1024 + ch * 8;
        const f32x4 a = *(const GAS f32x4*)src, c = *(const GAS f32x4*)(src + 4);
        v4u o; o.x = cvtpk(a[0], a[1]); o.y = cvtpk(a[2], a[3]); o.z = cvtpk(c[0], c[1]); o.w = cvtpk(c[2], c[3]);
        *(GAS v4u*)dst = o;
    }
}

__device__ __forceinline__ void thin_phase(LAS unsigned char* lds, int bid, int tid, int lane, int wave, int G,
                                           const float* xsrc_c, const float* xsrc_s, float* X, const float* D, bf16* H,
                                           const float* gpost, const float* mod_res, int gt_chunk, float gscale, bool has_res,
                                           const float* gpre, const float* mod_next, int sc_chunk, int sh_chunk, bool has_next) {
    LAS f32x4* v1 = (LAS f32x4*)lds; LAS f32x4* v2 = (LAS f32x4*)(lds + 8192); LAS f32x4* v3 = (LAS f32x4*)(lds + 16384);
    for (int c = bid; c < M / 32; c += G) {
        const int r = (c < 256) ? 0 : 1 + ((c - 256) >> 6);
        __syncthreads();
        {
            f32x4 a = (f32x4){0.f, 0.f, 0.f, 0.f}, b2 = a, b3 = a;
            if (has_res) { a = *(const GAS f32x4*)(mod_res + (size_t)r * NMODC + gt_chunk * DM + 4 * tid) * *(const GAS f32x4*)(gpost + 4 * tid) * gscale; }
            if (has_next) { b2 = *(const GAS f32x4*)(gpre + 4 * tid) * (*(const GAS f32x4*)(mod_next + (size_t)r * NMODC + sc_chunk * DM + 4 * tid) + 1.0f);
                            b3 = *(const GAS f32x4*)(mod_next + (size_t)r * NMODC + sh_chunk * DM + 4 * tid); }
            v1[tid] = a; v2[tid] = b2; v3[tid] = b3;
        }
        __syncthreads();
#pragma unroll 1
        for (int i = 0; i < 4; ++i) {
            const int m = c * 32 + wave * 4 + i;
            const float* xrow = (m < MC) ? xsrc_c + (size_t)m * DM : xsrc_s + (size_t)(m - MC) * DM;
            f32x4 x[8];
#pragma unroll
            for (int j = 0; j < 8; ++j) x[j] = *((const GAS f32x4*)xrow + lane + 64 * j);
            if (has_res) {
                f32x4 d[8]; float s = 0.f;
#pragma unroll
                for (int j = 0; j < 8; ++j) { d[j] = *((const GAS f32x4*)(D + (size_t)m * DM) + lane + 64 * j); s += (d[j][0] * d[j][0] + d[j][1] * d[j][1]) + (d[j][2] * d[j][2] + d[j][3] * d[j][3]); }
                const float rstd = 1.0f / sqrtf(wave_sum(s) * (1.0f / DM) + NORM_EPS);
#pragma unroll
                for (int j = 0; j < 8; ++j) x[j] += v1[lane + 64 * j] * d[j] * rstd;
            }
#pragma unroll
            for (int j = 0; j < 8; ++j) *((GAS f32x4*)(X + (size_t)m * DM) + lane + 64 * j) = x[j];
            if (has_next) {
                float s = 0.f;
#pragma unroll
                for (int j = 0; j < 8; ++j) s += (x[j][0] * x[j][0] + x[j][1] * x[j][1]) + (x[j][2] * x[j][2] + x[j][3] * x[j][3]);
                const float rstd = 1.0f / sqrtf(wave_sum(s) * (1.0f / DM) + NORM_EPS);
#pragma unroll
                for (int j = 0; j < 8; ++j) { const f32x4 h = x[j] * rstd * v2[lane + 64 * j] + v3[lane + 64 * j];
                    *((GAS unsigned long long*)(H + (size_t)m * DM) + lane + 64 * j) = (unsigned long long)cvtpk(h[0], h[1]) | ((unsigned long long)cvtpk(h[2], h[3]) << 32); }
            }
        }
    }
    __syncthreads();
}

constexpr int LR_XS = 0, LR_XS_STRIDE = 272, LR_YB = 18688, LR_YB_STRIDE = 272, LR_Y32 = LR_YB + 17408, LR_F_STRIDE = 132  , LR_AS = LR_Y32 + 33792, LR_SEG = LR_AS + 33792, LR_HC = LR_SEG + 4096, LR_END = LR_HC + 1024;
static_assert(LR_END <= RING_BYTES, "lru lds");
__device__ __forceinline__ void lru_phase(const Ptrs& P, int l, LAS unsigned char* lds, int bid, int tid, int lane, int wave, int G) {
    const bf16* XR = (const bf16*)(P.ws + WS_R1);
    const bf16* WG = (const bf16*)(P.ws + WS_WG);
    float* ostate = P.out + (size_t)M * DM + 4 * (size_t)MC * 1024;
    const int fr = lane & 15, fq = lane >> 4;
    for (int u = bid; u < 1280; u += G) {
        int b, n, dir, T, row0; bool samp;
        if (u < 256) { samp = true; b = u >> 5; n = (u & 31) >> 1; dir = u & 1; T = TSM; row0 = MC + b * TSM; }
        else { const int uc = u - 256; samp = false; b = uc >> 5; n = (uc & 31) >> 1; dir = uc & 1; T = TCX; row0 = b * TCX; }
        bf16* HO = (bf16*)(P.ws + (dir ? WS_HB : WS_HF));
        const int ch0 = n * 128;
        pg8::bf16x8 wf[2][4];
        { const bf16* wb = WG + (size_t)((n * 2 + dir) * 2) * 16384;
#pragma unroll
          for (int g = 0; g < 2; ++g)
#pragma unroll
              for (int ks = 0; ks < 4; ++ks) wf[g][ks] = *(const GAS pg8::bf16x8*)(wb + (size_t)(g * 128 + wave * 16 + fr) * 128 + ks * 32 + fq * 8); }
        f32x4 ba4, bx4, sp8;
        { const int cch = ch0 + wave * 16 + fq * 4;
          ba4 = *(const GAS f32x4*)(P.in(17) + (size_t)(l * 2 + dir) * DM + cch); bx4 = *(const GAS f32x4*)(P.in(19) + (size_t)(l * 2 + dir) * DM + cch);
          const f32x4 lam = *(const GAS f32x4*)(P.in(20) + (size_t)(l * 2 + dir) * DM + cch);
#pragma unroll
          for (int i = 0; i < 4; ++i) sp8[i] = 8.0f * log1pf(expf(-lam[i])); }
        const int cc = tid & 15;
        float cw[4][8], cbias[8];
#pragma unroll
        for (int j = 0; j < 4; ++j) { const f32x4 a = *(const GAS f32x4*)(P.in(14) + (size_t)(l * 4 + j) * DM + ch0 + cc * 8), c2 = *(const GAS f32x4*)(P.in(14) + (size_t)(l * 4 + j) * DM + ch0 + cc * 8 + 4);
#pragma unroll
            for (int e = 0; e < 4; ++e) { cw[j][e] = a[e]; cw[j][4 + e] = c2[e]; } }
        { const f32x4 a = *(const GAS f32x4*)(P.in(15) + (size_t)l * DM + ch0 + cc * 8), c2 = *(const GAS f32x4*)(P.in(15) + (size_t)l * DM + ch0 + cc * 8 + 4);
#pragma unroll
          for (int e = 0; e < 4; ++e) { cbias[e] = a[e]; cbias[4 + e] = c2[e]; } }
        LAS float* hc = (LAS float*)(lds + LR_HC);
        __syncthreads();
        if (tid < 128) hc[tid] = samp ? P.in(5)[(size_t)((b * 2 + l) * 2 + dir) * DM + ch0 + tid] : 0.f;
        const int ntile = T >> 6;
#pragma unroll 1
        for (int it = 0; it < ntile; ++it) {
            const int t0 = (dir ? (ntile - 1 - it) : it) << 6;
            for (int idx = tid; idx < 67 * 16; idx += 512) { const int rr = idx >> 4, c8 = idx & 15, t = t0 - 2 + rr;
                v4u v = (v4u){0u, 0u, 0u, 0u};
                if (t >= 0 && t < T) v = *(const GAS v4u*)(XR + (size_t)(row0 + t) * DM + ch0 + c8 * 8);
                *(LAS v4u*)(lds + LR_XS + rr * LR_XS_STRIDE + c8 * 16) = v; }
            __syncthreads();
#pragma unroll
            for (int k = 0; k < 2; ++k) { const int tl = (tid >> 4) + 32 * k;
                float y[8];
#pragma unroll
                for (int e = 0; e < 8; ++e) y[e] = cbias[e];
#pragma unroll
                for (int j = 0; j < 4; ++j) { const v4u xv = *(const LAS v4u*)(lds + LR_XS + (tl + j) * LR_XS_STRIDE + cc * 16);
                    y[0] += cw[j][0] * bflo(xv.x); y[1] += cw[j][1] * bfhi(xv.x); y[2] += cw[j][2] * bflo(xv.y); y[3] += cw[j][3] * bfhi(xv.y);
                    y[4] += cw[j][4] * bflo(xv.z); y[5] += cw[j][5] * bfhi(xv.z); y[6] += cw[j][6] * bflo(xv.w); y[7] += cw[j][7] * bfhi(xv.w); }
                v4u o; o.x = cvtpk(y[0], y[1]); o.y = cvtpk(y[2], y[3]); o.z = cvtpk(y[4], y[5]); o.w = cvtpk(y[6], y[7]);
                *(LAS v4u*)(lds + LR_YB + tl * LR_YB_STRIDE + cc * 16) = o;
                LAS float* yf = (LAS float*)(lds + LR_Y32) + tl * LR_F_STRIDE + cc * 8;
                *(LAS f32x4*)yf = (f32x4){y[0], y[1], y[2], y[3]}; *(LAS f32x4*)(yf + 4) = (f32x4){y[4], y[5], y[6], y[7]}; }
            __syncthreads();
#pragma unroll
            for (int rb = 0; rb < 4; ++rb) {
                f32x4 ga = (f32x4){0.f, 0.f, 0.f, 0.f}, gx = ga;
#pragma unroll
                for (int ks = 0; ks < 4; ++ks) { const pg8::bf16x8 yfrag = *(const LAS pg8::bf16x8*)(lds + LR_YB + (rb * 16 + fr) * LR_YB_STRIDE + (ks * 32 + fq * 8) * 2);
                    ga = __builtin_amdgcn_mfma_f32_16x16x32_bf16(wf[0][ks], yfrag, ga, 0, 0, 0);
                    gx = __builtin_amdgcn_mfma_f32_16x16x32_bf16(wf[1][ks], yfrag, gx, 0, 0, 0); }
                LAS float* yp = (LAS float*)(lds + LR_Y32) + (rb * 16 + fr) * LR_F_STRIDE + wave * 16 + fq * 4;
                LAS float* ap = (LAS float*)(lds + LR_AS) + (rb * 16 + fr) * LR_F_STRIDE + wave * 16 + fq * 4;
                const f32x4 yv = *(const LAS f32x4*)yp; f32x4 av, bv;
#pragma unroll
                for (int i = 0; i < 4; ++i) { const float gta = 1.0f / (1.0f + expf(-(ga[i] + ba4[i]))), gtx = 1.0f / (1.0f + expf(-(gx[i] + bx4[i])));
                    const float a = expf(-gta * sp8[i]); av[i] = a; bv[i] = sqrtf(fmaxf(fmaf(-a, a, 1.0f), 0.f)) * gtx * yv[i]; }
                *(LAS f32x4*)ap = av; *(LAS f32x4*)yp = bv;
            }
            __syncthreads();
            const int sc_ = tid & 127, seg = tid >> 7;
            const LAS float* As = (const LAS float*)(lds + LR_AS); LAS float* Bs = (LAS float*)(lds + LR_Y32);
            LAS float* sg = (LAS float*)(lds + LR_SEG);
            {
                float A = 1.f, B = 0.f;
#pragma unroll
                for (int k = 0; k < 16; ++k) { const int o = seg * 16 + k, tl = dir ? 63 - o : o; const float a = As[tl * LR_F_STRIDE + sc_], bb = Bs[tl * LR_F_STRIDE + sc_]; A = a * A; B = fmaf(a, B, bb); }
                sg[seg * 128 + sc_] = A; sg[512 + seg * 128 + sc_] = B;
            }
            __syncthreads();
            {
                float h = hc[(it & 1) * 128 + sc_];
                for (int s = 0; s < seg; ++s) h = fmaf(sg[s * 128 + sc_], h, sg[512 + s * 128 + sc_]);
#pragma unroll
                for (int k = 0; k < 16; ++k) { const int o = seg * 16 + k, tl = dir ? 63 - o : o; const float a = As[tl * LR_F_STRIDE + sc_], bb = Bs[tl * LR_F_STRIDE + sc_]; h = fmaf(a, h, bb); Bs[tl * LR_F_STRIDE + sc_] = h; }
                if (seg == 3) hc[((it + 1) & 1) * 128 + sc_] = h;
            }
            __syncthreads();
#pragma unroll
            for (int k = 0; k < 2; ++k) { const int tl = (tid >> 4) + 32 * k; const LAS float* hp = (const LAS float*)(lds + LR_Y32) + tl * LR_F_STRIDE + cc * 8;
                const f32x4 a = *(const LAS f32x4*)hp, c2 = *(const LAS f32x4*)(hp + 4);
                v4u o; o.x = cvtpk(a[0], a[1]); o.y = cvtpk(a[2], a[3]); o.z = cvtpk(c2[0], c2[1]); o.w = cvtpk(c2[2], c2[3]);
                *(GAS v4u*)(HO + (size_t)(row0 + t0 + tl) * DM + ch0 + cc * 8) = o; }
        }
        __syncthreads();
        if (!samp && tid < 128) ostate[(size_t)((b * 2 + l) * 2 + dir) * DM + ch0 + tid] = hc[(ntile & 1) * 128 + tid];
    }
    __syncthreads();
}

namespace att {
using bf16x8 = __attribute__((ext_vector_type(8))) short;
using s16x4  = __attribute__((ext_vector_type(4))) short;
using f32x16 = __attribute__((ext_vector_type(16))) float;
constexpr int NW = 8, QBLK = 32, KVBLK = 64, LDQ = 1024, LDK = 1024, LDO = 1024;
constexpr float SCALE = 0.125f, THR = 8.f;
constexpr int SHM_V = KVBLK * 128 * 2, SHM_K = KVBLK * 64 * 2, SHM_ATTN = 2 * SHM_V + 2 * SHM_K + NW * 64 * 4;
#define KSWZ64(row, colB) ((row) * 128 + ((colB) ^ ((((row) >> 1) & 7) << 4)))
#define SBAR() __builtin_amdgcn_sched_barrier(0)
__device__ __forceinline__ int crow(int r, int hi) { return (r & 3) + 8 * (r >> 2) + 4 * hi; }
__device__ __forceinline__ void partialSM(f32x16& p0, f32x16& p1, float& m_reg, float& mn, float& alpha) {
  constexpr float C = SCALE * 1.4426950408889634f;
  float pmax = p0[0]; for (int r = 1; r < 16; ++r) pmax = fmaxf(pmax, p0[r]); for (int r = 0; r < 16; ++r) pmax = fmaxf(pmax, p1[r]);
  { auto rr = __builtin_amdgcn_permlane32_swap(__float_as_uint(pmax), __float_as_uint(pmax), false, false);
    pmax = fmaxf(__uint_as_float(rr[0]), __uint_as_float(rr[1])); }
  if (__builtin_expect(__all(pmax - m_reg <= THR / SCALE), 1)) { mn = m_reg; alpha = 1.f; }
  else { mn = fmaxf(m_reg, pmax); alpha = __builtin_amdgcn_exp2f((m_reg - mn) * C); m_reg = mn; }
  float mnC = -mn * C;
  for (int r = 0; r < 16; ++r) p0[r] = fmaf(p0[r], C, mnC); for (int r = 0; r < 16; ++r) p1[r] = fmaf(p1[r], C, mnC);
  for (int r = 0; r < 16; ++r) p0[r] = __builtin_amdgcn_exp2f(p0[r]);
}
__device__ __forceinline__ void finishSM(f32x16& p0, f32x16& p1, float alpha, float& l_reg, bf16x8& pa0, bf16x8& pa1, bf16x8& pa2, bf16x8& pa3) {
  for (int r = 0; r < 16; ++r) p1[r] = __builtin_amdgcn_exp2f(p1[r]);
  float ps = 0; for (int r = 0; r < 16; ++r) ps += p0[r]; for (int r = 0; r < 16; ++r) ps += p1[r];
  { auto rr = __builtin_amdgcn_permlane32_swap(__float_as_uint(ps), __float_as_uint(ps), false, false);
    ps = __uint_as_float(rr[0]) + __uint_as_float(rr[1]); }
  l_reg = l_reg * alpha + ps;
#define PK4(P, BASE, OUT) do { unsigned a0 = cvtpk(P[BASE + 0], P[BASE + 1]), a1 = cvtpk(P[BASE + 2], P[BASE + 3]);   \
    unsigned b0 = cvtpk(P[BASE + 4], P[BASE + 5]), b1 = cvtpk(P[BASE + 6], P[BASE + 7]);                              \
    auto r0 = __builtin_amdgcn_permlane32_swap(a0, b0, false, false); auto r1 = __builtin_amdgcn_permlane32_swap(a1, b1, false, false); \
    v4u w = {r0[0], r1[0], r0[1], r1[1]}; OUT = *reinterpret_cast<bf16x8*>(&w); } while (0)
  PK4(p0, 0, pa0); PK4(p0, 8, pa1); PK4(p1, 0, pa2); PK4(p1, 8, pa3);
#undef PK4
}
__device__ __forceinline__ void qkt(f32x16& p0, f32x16& p1, const char* Ks, const bf16x8* qr, int r32, int hi) {
  p0 = f32x16{}; p1 = f32x16{};
  for (int d0 = 0; d0 < 4; ++d0) { int cb = (d0 * 16 + hi * 8) * 2;
    bf16x8 b0 = *reinterpret_cast<const bf16x8*>(Ks + KSWZ64(r32, cb));
    bf16x8 b1 = *reinterpret_cast<const bf16x8*>(Ks + KSWZ64(32 + r32, cb));
    p0 = __builtin_amdgcn_mfma_f32_32x32x16_bf16(b0, qr[d0], p0, 0, 0, 0);
    p1 = __builtin_amdgcn_mfma_f32_32x32x16_bf16(b1, qr[d0], p1, 0, 0, 0); }
}
__device__ __forceinline__ int v_st(int k, int c) { const int kk = (k & ~0xC) | ((k & 4) << 1) | ((k & 8) >> 1); return ((kk >> 3) * 4 + (c >> 5)) * 512 + ((kk & 7) * 32 + (c & 31)) * 2; }
__device__ __forceinline__ int v_rd_base(int lane) { return ((lane & 3) << 3) | (((lane >> 2) & 3) << 6) | (((lane >> 4) & 1) << 5) | (((lane >> 5) & 1) << 8); }
constexpr int v_rd_off(int d0, int ks, int half) { return d0 * 512 + ks * 4096 + half * 2048; }
template <int OFF> __device__ __forceinline__ s16x4 tr_read(int vb) {
  s16x4 r; asm volatile("ds_read_b64_tr_b16 %0, %1 offset:%2" : "=&v"(r) : "v"(vb), "i"(OFF) : "memory"); return r;
}
template <int D0> __device__ __forceinline__ void pv_one(f32x16& od, int vb, bf16x8 pa0, bf16x8 pa1, bf16x8 pa2, bf16x8 pa3) {
  const s16x4 l0 = tr_read<v_rd_off(D0, 0, 0)>(vb), h0 = tr_read<v_rd_off(D0, 0, 1)>(vb), l1 = tr_read<v_rd_off(D0, 1, 0)>(vb), h1 = tr_read<v_rd_off(D0, 1, 1)>(vb);
  const s16x4 l2 = tr_read<v_rd_off(D0, 2, 0)>(vb), h2 = tr_read<v_rd_off(D0, 2, 1)>(vb), l3 = tr_read<v_rd_off(D0, 3, 0)>(vb), h3 = tr_read<v_rd_off(D0, 3, 1)>(vb);
  asm volatile("s_waitcnt lgkmcnt(0)" ::: "memory"); SBAR();
#define PK(L, H) (bf16x8){L[0], L[1], L[2], L[3], H[0], H[1], H[2], H[3]}
  od = __builtin_amdgcn_mfma_f32_32x32x16_bf16(pa0, PK(l0, h0), od, 0, 0, 0);
  od = __builtin_amdgcn_mfma_f32_32x32x16_bf16(pa1, PK(l1, h1), od, 0, 0, 0);
  od = __builtin_amdgcn_mfma_f32_32x32x16_bf16(pa2, PK(l2, h2), od, 0, 0, 0);
  od = __builtin_amdgcn_mfma_f32_32x32x16_bf16(pa3, PK(l3, h3), od, 0, 0, 0);
#undef PK
}
__device__ __forceinline__ void pv_d0(f32x16* o, int vb, bf16x8 pa0, bf16x8 pa1, bf16x8 pa2, bf16x8 pa3) {
  pv_one<0>(o[0], vb, pa0, pa1, pa2, pa3); pv_one<1>(o[1], vb, pa0, pa1, pa2, pa3); pv_one<2>(o[2], vb, pa0, pa1, pa2, pa3); pv_one<3>(o[3], vb, pa0, pa1, pa2, pa3);
}
__device__ __forceinline__ void attn_body(const bf16* __restrict__ Qb, const bf16* __restrict__ Kh, const bf16* __restrict__ Vh, float* __restrict__ Ob, int seq, char* lds) {
  const int tid = opaque_tid(), wid = tid >> 6, lane = tid & 63, r32 = lane & 31, hi = lane >> 5;
  char* V_lds = lds; char* K_lds = lds + 2 * SHM_V;
  float* ws = (float*)(lds + 2 * SHM_V + 2 * SHM_K) + wid * 64; float* li_l = ws; float* al_l = ws + 32;
  float m_reg = -1e30f, l_reg = 0; f32x16 o[4] = {}; bf16x8 qr[4];
  const bf16* Qw = Qb + (long)(wid * QBLK + r32) * LDQ + hi * 8;
#pragma unroll
  for (int d0 = 0; d0 < 4; ++d0) qr[d0] = *reinterpret_cast<const bf16x8*>(Qw + d0 * 16);
  const int sr = tid >> 4, sc = (tid & 15) * 8, vst0 = v_st(sr, sc), vst1 = v_st(32 + sr, sc);
  const int kr = tid >> 3, kc8 = (tid & 7) * 8, kst = KSWZ64(kr, kc8 * 2);
  const int vb0 = (int)(uintptr_t)V_lds + v_rd_base(lane);
  struct { bf16x8 vs0, vs1, ks0; } sr_[2];
#define SLOAD(i, k0) do { sr_[i].vs0 = *reinterpret_cast<const bf16x8*>(&Vh[(long)((k0) + sr) * LDK + sc]); sr_[i].vs1 = *reinterpret_cast<const bf16x8*>(&Vh[(long)((k0) + 32 + sr) * LDK + sc]); \
    sr_[i].ks0 = *reinterpret_cast<const bf16x8*>(&Kh[(long)((k0) + kr) * LDK + kc8]); } while (0)
#define SWRITE(b, i) do { *(bf16x8*)(V_lds + (b) * SHM_V + vst0) = sr_[i].vs0; *(bf16x8*)(V_lds + (b) * SHM_V + vst1) = sr_[i].vs1; \
    *(bf16x8*)(K_lds + (b) * SHM_K + kst) = sr_[i].ks0; } while (0)
#define SWAIT() asm volatile("s_waitcnt vmcnt(3)" ::: "memory")
#define RESC(a) do { if (__any((a) < 1.f)) { if (hi == 0) al_l[r32] = (a); asm volatile("s_waitcnt lgkmcnt(0)" ::: "memory"); \
    for (int d = 0; d < 4; ++d) for (int r = 0; r < 16; ++r) o[d][r] *= al_l[crow(r, hi)]; } } while (0)
  f32x16 pA0, pA1, pB0, pB1; float mnA, mnB, alA, alB; bf16x8 pa0, pa1, pa2, pa3; const int NT = seq / KVBLK;
  constexpr int SE = 0, SO = 1;
  SLOAD(SE, 0); asm volatile("s_waitcnt vmcnt(0)" ::: "memory"); SWRITE(0, SE); __syncthreads();
  qkt(pA0, pA1, K_lds, qr, r32, hi); partialSM(pA0, pA1, m_reg, mnA, alA);
  SLOAD(SO, KVBLK); if (2 < NT) SLOAD(SE, 2 * KVBLK);
  SWAIT(); SWRITE(1, SO); __syncthreads();
  for (int j = 1; j + 1 < NT; j += 2) {
    SBAR(); qkt(pB0, pB1, K_lds + SHM_K, qr, r32, hi);
    finishSM(pA0, pA1, alA, l_reg, pa0, pa1, pa2, pa3); SBAR();
    SLOAD(SO, (j + 2) * KVBLK); SBAR();
    pv_d0(o, vb0, pa0, pa1, pa2, pa3); partialSM(pB0, pB1, m_reg, mnB, alB);
    __syncthreads(); SWAIT(); SWRITE(0, SE);
    RESC(alB); __syncthreads();
    SBAR(); qkt(pA0, pA1, K_lds, qr, r32, hi);
    finishSM(pB0, pB1, alB, l_reg, pa0, pa1, pa2, pa3); SBAR();
    if (j + 3 < NT) SLOAD(SE, (j + 3) * KVBLK); SBAR();
    pv_d0(o, vb0 + (int)SHM_V, pa0, pa1, pa2, pa3); partialSM(pA0, pA1, m_reg, mnA, alA);
    __syncthreads(); SWAIT(); SWRITE(1, SO);
    RESC(alA); __syncthreads();
  }
  SBAR(); qkt(pB0, pB1, K_lds + SHM_K, qr, r32, hi);
  finishSM(pA0, pA1, alA, l_reg, pa0, pa1, pa2, pa3); SBAR();
  pv_d0(o, vb0, pa0, pa1, pa2, pa3); partialSM(pB0, pB1, m_reg, mnB, alB);
  __syncthreads(); RESC(alB);
  finishSM(pB0, pB1, alB, l_reg, pa0, pa1, pa2, pa3); SBAR();
  pv_d0(o, vb0 + (int)SHM_V, pa0, pa1, pa2, pa3);
  if (hi == 0) li_l[r32] = l_reg; asm volatile("s_waitcnt lgkmcnt(0)" ::: "memory");
  float rli[16];
#pragma unroll
  for (int r = 0; r < 16; ++r) rli[r] = __builtin_amdgcn_rcpf(li_l[crow(r, hi)]);
  float* Ow = Ob + (long)(wid * QBLK) * LDO;
#pragma unroll
  for (int r = 0; r < 16; ++r) { int orow = crow(r, hi);
    for (int d0 = 0; d0 < 4; ++d0) Ow[(long)orow * LDO + d0 * 32 + r32] = o[d0][r] * rli[r]; }
#undef SLOAD
#undef SWRITE
#undef SWAIT
#undef RESC
}
}

__device__ __forceinline__ void attn_phase(const Ptrs& P, char* lds, int bid, int G) {
    const bf16* Q = (const bf16*)(P.ws + WS_R1 + 192 * MiB); const bf16* KB = (const bf16*)(P.ws + WS_KB); const bf16* VB = (const bf16*)(P.ws + WS_VB);
    float* AB = (float*)(P.ws + WS_R2);
    for (int u = bid; u < 1536; u += G) {
        int qrow0, kvrow0, seq, h, mp;
        if (u < 1024) { const int qb = u & 7, r = u >> 3; mp = r & 1; h = (r >> 1) & 7; const int b = r >> 4; qrow0 = MC + b * TSM + qb * 256; kvrow0 = MC + b * KVS; seq = KVS; }
        else { const int r = u - 1024; mp = r & 1; h = (r >> 1) & 7; const int b = r >> 4; qrow0 = b * TCX; kvrow0 = qrow0; seq = TCX; }
        att::attn_body(Q + (size_t)qrow0 * 1024 + h * 128 + mp * 64, KB + (size_t)kvrow0 * 1024 + h * 128 + mp * 64, VB + (size_t)kvrow0 * 1024 + h * 128,
                       AB + (size_t)mp * M * 1024 + (size_t)qrow0 * 1024 + h * 128, seq, lds);
        __syncthreads();
    }
}

__device__ __forceinline__ void combine_phase(const Ptrs& P, int l, int gw, int NGW, int lane) {
    const bf16* HF = (const bf16*)(P.ws + WS_HF); const bf16* HB = (const bf16*)(P.ws + WS_HB); const bf16* GR = (const bf16*)(P.ws + WS_R1 + 96 * MiB);
    bf16* REC = (bf16*)(P.ws + WS_R1); bf16* ON = (bf16*)(P.ws + WS_R1 + 192 * MiB);
    const float* A0 = (const float*)(P.ws + WS_R2); const float* A1 = A0 + (size_t)M * 1024;
    int lq = l; asm volatile("" : "+s"(lq));
    const float lam_init = lq == 0 ? 0.2f : 0.35550906759097f;
    const float d1 = wave_sum(P.in(21)[lq * 64 + lane] * P.in(22)[lq * 64 + lane]), d2 = wave_sum(P.in(23)[lq * 64 + lane] * P.in(24)[lq * 64 + lane]);
    const float lam = expf(d1) - expf(d2) + lam_init, osc = 1.0f - lam_init;
    f32x4 sub[4];
#pragma unroll
    for (int j = 0; j < 4; ++j) sub[j] = *(const GAS f32x4*)(P.in(25) + lq * 128 + (lane & 7) * 16 + 4 * j) * osc;
    for (int m = gw; m < M; m += NGW) {
#pragma unroll
        for (int j = 0; j < 4; ++j) { const size_t off = (size_t)m * DM + 8 * (lane + 64 * j);
            const v4u f = *(const GAS v4u*)(HF + off), bq = *(const GAS v4u*)(HB + off), g = *(const GAS v4u*)(GR + off);
            v4u o;
            o.x = cvtpk((bflo(f.x) + bflo(bq.x)) * bflo(g.x), (bfhi(f.x) + bfhi(bq.x)) * bfhi(g.x));
            o.y = cvtpk((bflo(f.y) + bflo(bq.y)) * bflo(g.y), (bfhi(f.y) + bfhi(bq.y)) * bfhi(g.y));
            o.z = cvtpk((bflo(f.z) + bflo(bq.z)) * bflo(g.z), (bfhi(f.z) + bfhi(bq.z)) * bfhi(g.z));
            o.w = cvtpk((bflo(f.w) + bflo(bq.w)) * bflo(g.w), (bfhi(f.w) + bfhi(bq.w)) * bfhi(g.w));
            *(GAS v4u*)(REC + off) = o; }
        f32x4 ov[4]; float s = 0.f;
#pragma unroll
        for (int j = 0; j < 4; ++j) { const size_t off = (size_t)m * 1024 + lane * 16 + 4 * j;
            ov[j] = *(const GAS f32x4*)(A0 + off) - *(const GAS f32x4*)(A1 + off) * lam;
            s += (ov[j][0] * ov[j][0] + ov[j][1] * ov[j][1]) + (ov[j][2] * ov[j][2] + ov[j][3] * ov[j][3]); }
        s += __shfl_xor(s, 1); s += __shfl_xor(s, 2); s += __shfl_xor(s, 4);
        const float rstd = 1.0f / sqrtf(s * (1.0f / 128.0f) + NORM_EPS);
        v4u o0, o1;
        { const f32x4 a = ov[0] * rstd * sub[0], b2 = ov[1] * rstd * sub[1], c2 = ov[2] * rstd * sub[2], d = ov[3] * rstd * sub[3];
          o0.x = cvtpk(a[0], a[1]); o0.y = cvtpk(a[2], a[3]); o0.z = cvtpk(b2[0], b2[1]); o0.w = cvtpk(b2[2], b2[3]);
          o1.x = cvtpk(c2[0], c2[1]); o1.y = cvtpk(c2[2], c2[3]); o1.z = cvtpk(d[0], d[1]); o1.w = cvtpk(d[2], d[3]); }
        *(GAS v4u*)(ON + (size_t)m * 1024 + lane * 16) = o0; *(GAS v4u*)(ON + (size_t)m * 1024 + lane * 16 + 8) = o1;
    }
}

struct Args { const float* in[29]; float* out; unsigned char* ws; int ph_lo, ph_hi; };
__global__ void __launch_bounds__(NWAVES * 64, 2) mega_fwd(Args args) {
    extern __shared__ __attribute__((aligned(16))) unsigned char lds_raw[];
    LAS unsigned char* lds = (LAS unsigned char*)lds_raw;
    volatile LAS unsigned* MISC = (volatile LAS unsigned*)(lds + MISC_OFF);
    const int tid = threadIdx.x, lane = tid & 63, wave = __builtin_amdgcn_readfirstlane(tid >> 6);
    const int bid = (int)blockIdx.x;
    const int G = gridDim.x, gw = blockIdx.x * NWAVES + wave, NGW = G * NWAVES, gtid = blockIdx.x * (NWAVES * 64) + tid, NTH = G * NWAVES * 64;
    Ptrs P; P.tab = (const volatile LAS unsigned*)(lds + PTAB_OFF); P.out = args.out; P.ws = args.ws;
    unsigned char* ws = args.ws;
    for (int u = tid; u < (PTAB_OFF - LDSCTL_OFF) / 4; u += NWAVES * 64) ((LAS unsigned*)(lds + LDSCTL_OFF))[u] = 0u;
    if (tid < 29) { const unsigned long long pv = (unsigned long long)args.in[tid]; ((LAS unsigned*)(lds + PTAB_OFF))[2 * tid] = (unsigned)pv; ((LAS unsigned*)(lds + PTAB_OFF))[2 * tid + 1] = (unsigned)(pv >> 32); }
    __syncthreads();
    XcdBarrier bar = xcd_barrier_post((unsigned*)(ws + WS_CTL) + CW_BAR, MISC + 8);
    const int lo = args.ph_lo, hi = args.ph_hi;
#ifndef SITE_MASK
#define SITE_MASK 0xFFFFFFFFu
#endif
#define EN(s) ((SITE_MASK >> (s)) & 1u)
#define IN(k) (lo <= (k) && (k) < hi)
#define SEAM(k) do { if (IN((k) + 1)) xcd_barrier(bar); } while (0)

    float* X = args.out;
    bf16* H = (bf16*)(ws + WS_H);
    float* D = (float*)(ws + WS_R2);
    const float* MOD = (const float*)(ws + WS_MOD);

    if (EN(0) && IN(0)) {
        mod_partials(P, lds, gw, NGW, wave, lane);
        convert_weights(P, 0, lds, gw, NGW, wave, lane);
        if (blockIdx.x == 0) { float* rc = (float*)(ws + WS_ROPE); float* rs = rc + 1024;
            for (int i = tid; i < 1024; i += NWAVES * 64) { const int pos = i >> 4, f = i & 15; const float fr = 1.0f / powf(10000.0f, (float)f / 16.0f), ang = (float)pos * fr; rc[i] = cosf(ang); rs[i] = sinf(ang); } }
        SEAM(0);
    }
    if (EN(1) && IN(1)) { mod_reduce(P, gtid, NTH); SEAM(1); }
    if (EN(2) && IN(2)) {
        thin_phase(lds, bid, tid, lane, wave, G, P.in(0), P.in(1), X, D, H, nullptr, MOD, 0, 0.f, false, P.in(9), MOD, 1, 0, true);
        SEAM(2);
    }
    const Ptrs P0 = P;
#pragma unroll 1
    for (int l = 0; l < 2; ++l) {
        const int base = 3 + 12 * l;
#pragma unroll 1
        for (int f = 0; f < 2; ++f) {
            const int tid = opaque_tid(), lane = tid & 63, wave = __builtin_amdgcn_readfirstlane(tid >> 6), bid = opaque_bid();
            const int gw = bid * NWAVES + wave, gtid = bid * (NWAVES * 64) + tid;
            unsigned long long ws_i = (unsigned long long)args.ws, x_i = (unsigned long long)args.out; asm volatile("" : "+s"(ws_i), "+s"(x_i));
            unsigned char* ws = (unsigned char*)(GAS unsigned char*)ws_i; float* X = (float*)(GAS float*)x_i;
            bf16* H = (bf16*)(ws + WS_H); float* D = (float*)(ws + WS_R2);
            const float* MODL = (const float*)(ws + WS_MOD) + (size_t)l * 9 * NMODC;
            Ptrs P; P.tab = P0.tab; P.out = X; P.ws = ws;
            if (EN(3) && IN(base + 9 * f)) {
                pg8::Gemm g{(const pg8::bf16_t*)H, (const pg8::bf16_t*)(ws + WS_W1T) + (size_t)f * NFF2 * DM, M, NFF2, DM}; pg8::StaticOrder S; S.init(M, NFF2, G, bid);
                pg8::EpiSwiGLU E{(pg8::bf16_t*)(ws + WS_R1), DFF};
                pg8::gemm_phase<pg8::EpiSwiGLU, pg8::StaticOrder, true, true>(lds, g, S, E);
                SEAM(base + 9 * f);
            }
            if (EN(4) && IN(base + 9 * f + 1)) {
                pg8::Gemm g{(const pg8::bf16_t*)(ws + WS_R1), (const pg8::bf16_t*)(ws + WS_W2T) + (size_t)f * DM * DFF, M, DM, DFF}; pg8::StaticOrder S; S.init(M, DM, G, bid);
                pg8::EpiF32 E{D, DM};
                pg8::gemm_phase<pg8::EpiF32, pg8::StaticOrder, true, true>(lds, g, S, E);
                SEAM(base + 9 * f + 1);
            }
            if (EN(5) && IN(base + 9 * f + 2)) {
                if (f == 0) {
                    thin_phase(lds, bid, tid, lane, wave, G, X, X + (size_t)MC * DM, X, D, H, P.in(10) + (size_t)(l * 3 + 0) * DM, MODL, 2, 0.5f, true,
                               P.in(9) + (size_t)(l * 3 + 1) * DM, MODL, 4, 3, true);
                    convert_cache(P, l, gtid, NTH);
                } else {
                    const bool more = (l == 0);
                    thin_phase(lds, bid, tid, lane, wave, G, X, X + (size_t)MC * DM, X, D, H, P.in(10) + (size_t)(l * 3 + 2) * DM, MODL, 8, 0.5f, true,
                               P.in(9) + (size_t)((l + 1) * 3 + 0) * DM, MODL + 9 * NMODC, 1, 0, more);
                    if (more) convert_weights(P, l + 1, lds, gw, NGW, wave, lane);
                }
                SEAM(base + 9 * f + 2);
            }
            if (f == 1) break;
            if (EN(6) && IN(base + 3)) {
                pg8::Gemm g{(const pg8::bf16_t*)H, (const pg8::bf16_t*)(ws + WS_WINT), M, NIN, DM}; pg8::StaticOrder S; S.init(M, NIN, G, bid);
                float* ock = X + (size_t)M * DM + (size_t)l * 256 * 1024; float* ocv = ock + (size_t)MC * 1024 * 2;
                pg8::EpiWin E{(pg8::bf16_t*)(ws + WS_R1), (pg8::bf16_t*)(ws + WS_R1 + 96 * MiB), (pg8::bf16_t*)(ws + WS_R1 + 192 * MiB), (pg8::bf16_t*)(ws + WS_KB), (pg8::bf16_t*)(ws + WS_VB),
                              (pg8::bf16_t*)(ws + WS_GM), ock, ocv, (const float*)(ws + WS_ROPE), (const float*)(ws + WS_ROPE) + 1024};
                pg8::gemm_phase<pg8::EpiWin, pg8::StaticOrder, true, true>(lds, g, S, E);
                SEAM(base + 3);
            }
            if (IN(base + 4)) {
                if (EN(7)) lru_phase(P, l, lds, bid, tid, lane, wave, G);
                if (EN(8)) attn_phase(P, (char*)lds_raw, bid, G);
                SEAM(base + 4);
            }
            if (EN(9) && IN(base + 5)) { combine_phase(P, l, gw, NGW, lane); SEAM(base + 5); }
            if (EN(10) && IN(base + 6)) {
                { pg8::Gemm g{(const pg8::bf16_t*)(ws + WS_R1), (const pg8::bf16_t*)(ws + WS_PLRUT), M, DM, DM}; pg8::StaticOrder S; S.init(M, DM, G, bid);
                  pg8::EpiGate1 E{(float*)(ws + WS_R2), (const pg8::bf16_t*)(ws + WS_GM)};
                  pg8::gemm_phase<pg8::EpiGate1, pg8::StaticOrder, true, true>(lds, g, S, E); }
                { pg8::Gemm g{(const pg8::bf16_t*)(ws + WS_R1 + 192 * MiB), (const pg8::bf16_t*)(ws + WS_PATTNT), M, DM, 1024}; pg8::StaticOrder S; S.init(M, DM, G, bid);
                  pg8::EpiGate2 E{(const float*)(ws + WS_R2), (const pg8::bf16_t*)(ws + WS_GM), (pg8::bf16_t*)H};
                  pg8::gemm_phase<pg8::EpiGate2, pg8::StaticOrder, true, true>(lds, g, S, E); }
                SEAM(base + 6);
            }
            if (EN(11) && IN(base + 7)) {
                pg8::Gemm g{(const pg8::bf16_t*)H, (const pg8::bf16_t*)(ws + WS_WOUTT), M, DM, DM}; pg8::StaticOrder S; S.init(M, DM, G, bid);
                pg8::EpiF32 E{D, DM};
                pg8::gemm_phase<pg8::EpiF32, pg8::StaticOrder, true, true>(lds, g, S, E);
                SEAM(base + 7);
            }
            if (EN(12) && IN(base + 8)) {
                thin_phase(lds, bid, tid, lane, wave, G, X, X + (size_t)MC * DM, X, D, H, P.in(10) + (size_t)(l * 3 + 1) * DM, MODL, 5, 1.0f, true,
                           P.in(9) + (size_t)(l * 3 + 2) * DM, MODL, 7, 6, true);
                SEAM(base + 8);
            }
        }
    }
#undef IN
#undef SEAM
}

#ifndef MK_SPLIT
#define MK_SPLIT 0
#endif
extern "C" void kernel_launch(void* const* d_in, const int* in_sizes, int n_in, void* d_out, int out_size, void* d_ws, size_t ws_size, hipStream_t stream) {
    static int grid = 0;
    if (grid == 0) {
        if (n_in != 29 || ws_size < WS_END) { fprintf(stderr, "kernel_launch: need 29 inputs and >= %zu bytes of workspace; got %d, %zu\n", (size_t)WS_END, n_in, ws_size); grid = -1; return; }
        int dev = 0, cus = 0, per_cu = 0;
        if (hipGetDevice(&dev) != hipSuccess || hipDeviceGetAttribute(&cus, hipDeviceAttributeMultiprocessorCount, dev) != hipSuccess) { grid = -1; return; }
        if (hipFuncSetAttribute((const void*)mega_fwd, hipFuncAttributeMaxDynamicSharedMemorySize, LDS_BYTES) != hipSuccess) { fprintf(stderr, "kernel_launch: hipFuncSetAttribute failed\n"); grid = -1; return; }
        if (hipOccupancyMaxActiveBlocksPerMultiprocessor(&per_cu, (const void*)mega_fwd, NWAVES * 64, LDS_BYTES) != hipSuccess || per_cu < 1) { fprintf(stderr, "kernel_launch: occupancy query says %d\n", per_cu); (void)hipGetLastError(); grid = -1; return; }
        grid = cus;
    }
    if (grid < 0) return;
    (void)hipMemsetAsync((char*)d_ws + WS_CTL, 0, CTL_ZERO_BYTES, stream);
    Args a{};
    for (int i = 0; i < 29; ++i) a.in[i] = (const float*)d_in[i];
    a.out = (float*)d_out; a.ws = (unsigned char*)d_ws;
#if MK_SPLIT
    for (int p = 0; p < NPHASE; ++p) { a.ph_lo = p; a.ph_hi = p + 1; hipLaunchKernelGGL(mega_fwd, dim3(grid), dim3(NWAVES * 64), LDS_BYTES, stream, a); }
#else
    a.ph_lo = 0; a.ph_hi = NPHASE;
    hipLaunchKernelGGL(mega_fwd, dim3(grid), dim3(NWAVES * 64), LDS_BYTES, stream, a);
#endif
    const hipError_t le = hipPeekAtLastError();
    if (le != hipSuccess) fprintf(stderr, "kernel_launch: launch failed: %s\n", hipGetErrorName(le));
}
```

```cpp
#include <hip/hip_runtime.h>
#include <cstdio>
#include <cstdint>
__device__ __forceinline__ int opaque_tid() { int t = (int)threadIdx.x; asm volatile("" : "+v"(t)); return t; }
__device__ __forceinline__ int opaque_bid() { int b = (int)blockIdx.x; asm volatile("" : "+s"(b)); return b; }
namespace pg8 {
#define PG8_LAS __attribute__((address_space(3)))
typedef unsigned short bf16_t;
typedef short bf16x8 __attribute__((ext_vector_type(8)));
typedef float f32x4 __attribute__((ext_vector_type(4)));
typedef unsigned u32x4 __attribute__((ext_vector_type(4)));
constexpr int BM = 256, BK = 64, HALF = 128, HTB = HALF * BK * 2  , STAGE_BYTES = 8 * HTB, NXCD = 8, WGM = 8;

__host__ __device__ __forceinline__ int lds_byte(int r, int c) { const int st = (r >> 4) * 2 + (c >> 5), rr = r & 15, cc = c & 31, ob = rr * 64 + cc * 2; return st * 1024 + (ob ^ (((ob >> 9) & 1) << 5)); }
__host__ __device__ __forceinline__ void stage_rc(int b, int& R, int& C) { const int st = b / 1024, sb = b % 1024, swz = sb ^ (((sb >> 9) & 1) << 5); R = (st >> 1) * 16 + swz / 64; C = (st & 1) * 32 + (swz % 64) / 2; }
__host__ __device__ __forceinline__ int perm32(int rho) { const int n = rho >> 4, i = rho & 15; return 8 * (i >> 2) + 4 * n + (i & 3); }

struct Unit { int pm, pn; };
struct Gemm { const bf16_t* A; const bf16_t* Bt; int M, N, K; };

struct StaticOrder {
    int nM, nN, nwg, G, c;
    __host__ __device__ void init(int M, int N, int G_, int c_) { nM = M / BM; nN = N / BM; nwg = nM * nN; G = G_; c = c_; }
    __host__ __device__ bool next(int i, Unit& u) const {
        const long L = (long)i * G + c; if (L >= nwg) return false;
        int wgid = (int)L; { const int q = nwg / NXCD, r = nwg % NXCD, xcd = wgid % NXCD, off = wgid / NXCD; wgid = (xcd < r ? xcd * (q + 1) : r * (q + 1) + (xcd - r) * q) + off; }
        const int nig = WGM * nN, gid = wgid / nig, fm = gid * WGM, gsz = (nM - fm) < WGM ? (nM - fm) : WGM;
        u.pm = fm + ((wgid % nig) % gsz); u.pn = (wgid % nig) / gsz; return true;
    }
    __device__ __forceinline__ void a_ready(const Unit&) const {}
    __device__ __forceinline__ void done(const Unit&) const {}
};
typedef __bf16 cvt_bf2 __attribute__((ext_vector_type(2)));
typedef float cvt_f2 __attribute__((ext_vector_type(2)));
__device__ __forceinline__ unsigned cvt_pk_bf16(float lo, float hi) { const cvt_f2 v = {lo, hi}; const cvt_bf2 r = __builtin_convertvector(v, cvt_bf2); return __builtin_bit_cast(unsigned, r); }
typedef unsigned u32x2 __attribute__((ext_vector_type(2)));
__device__ __forceinline__ float sigm(float x) { return __builtin_amdgcn_rcpf(1.0f + __builtin_amdgcn_exp2f(-1.4426950408889634f * x)); }
__device__ __forceinline__ float gelu_tanh(float x) { return x * sigm(1.5957691216057308f * x * (1.0f + 0.044715f * x * x)); }
__device__ __forceinline__ void st4bf(bf16_t* p, f32x4 v) { u32x2 w; w.x = cvt_pk_bf16(v[0], v[1]); w.y = cvt_pk_bf16(v[2], v[3]); *(u32x2*)p = w; }
__device__ __forceinline__ f32x4 ld4bf(const bf16_t* p) { const u32x2 w = *(const u32x2*)p; f32x4 v; v[0] = __uint_as_float(w.x << 16); v[1] = __uint_as_float(w.x & 0xffff0000u); v[2] = __uint_as_float(w.y << 16); v[3] = __uint_as_float(w.y & 0xffff0000u); return v; }

struct EpiSwiGLU {
    static constexpr bool PERM = true, AFTER_DRAIN = false; static constexpr int NVM = 8;
    bf16_t* O; int ldc;
    __device__ __forceinline__ void operator()(const f32x4 (&acc)[2][2][4][2], const Unit& u, int wr, int wc, int fr, int fq) const {
        const int row0 = u.pm * BM + wr * 64 + fr, col0 = u.pn * HALF + wc * 32 + 8 * fq;
#pragma unroll
        for (int ai = 0; ai < 2; ++ai)
#pragma unroll
            for (int m = 0; m < 4; ++m) {
                bf16_t* p = O + (size_t)(row0 + ai * HALF + m * 16) * ldc + col0;
                const f32x4 g0 = acc[ai][0][m][0], g1 = acc[ai][0][m][1], u0 = acc[ai][1][m][0], u1 = acc[ai][1][m][1];
                float v[8];
#pragma unroll
                for (int i = 0; i < 4; ++i) { v[i] = g0[i] * sigm(g0[i]) * u0[i]; v[4 + i] = g1[i] * sigm(g1[i]) * u1[i]; }
                u32x4 w; w.x = cvt_pk_bf16(v[0], v[1]); w.y = cvt_pk_bf16(v[2], v[3]); w.z = cvt_pk_bf16(v[4], v[5]); w.w = cvt_pk_bf16(v[6], v[7]);
                *(u32x4*)p = w;
            }
    }
};
struct EpiF32 {
    static constexpr bool PERM = false, AFTER_DRAIN = false;
    float* C; int ldc;
    __device__ __forceinline__ void operator()(const f32x4 (&acc)[2][2][4][2], const Unit& u, int wr, int wc, int fr, int fq) const {
        const int row0 = u.pm * BM + wr * 64 + fr, col0 = u.pn * BM + wc * 32 + 4 * fq;
#pragma unroll
        for (int ai = 0; ai < 2; ++ai)
#pragma unroll
            for (int m = 0; m < 4; ++m) { float* rowp = C + (size_t)(row0 + ai * HALF + m * 16) * ldc + col0;
#pragma unroll
                for (int bj = 0; bj < 2; ++bj)
#pragma unroll
                    for (int n = 0; n < 2; ++n) *(f32x4*)(rowp + bj * HALF + n * 16) = acc[ai][bj][m][n]; }
    }
};
struct EpiBf16P {
    static constexpr bool PERM = true, AFTER_DRAIN = false; static constexpr int NVM = 16;
    bf16_t* O; int ldc;
    __device__ __forceinline__ void operator()(const f32x4 (&acc)[2][2][4][2], const Unit& u, int wr, int wc, int fr, int fq) const {
        const int row0 = u.pm * BM + wr * 64 + fr, col0 = u.pn * BM + wc * 32 + 8 * fq;
#pragma unroll
        for (int ai = 0; ai < 2; ++ai)
#pragma unroll
            for (int m = 0; m < 4; ++m) { bf16_t* rowp = O + (size_t)(row0 + ai * HALF + m * 16) * ldc + col0;
#pragma unroll
                for (int bj = 0; bj < 2; ++bj) { const f32x4 v0 = acc[ai][bj][m][0], v1 = acc[ai][bj][m][1];
                    u32x4 w; w.x = cvt_pk_bf16(v0[0], v0[1]); w.y = cvt_pk_bf16(v0[2], v0[3]); w.z = cvt_pk_bf16(v1[0], v1[1]); w.w = cvt_pk_bf16(v1[2], v1[3]);
                    *(u32x4*)(rowp + bj * HALF) = w; } }
    }
};
struct EpiWin {
    static constexpr bool PERM = true, AFTER_DRAIN = false; static constexpr int NVM = 16;
    bf16_t *XR, *GR, *Q, *KB, *VB, *GM; float *ock, *ocv; const float *rc, *rs;
    __device__ __forceinline__ void operator()(const f32x4 (&acc)[2][2][4][2], const Unit& u, int wr, int wc, int fr, int fq) const {
        const int pn = u.pn, rl0 = wr * 64 + fr, c0 = wc * 32 + 4 * fq, c8 = wc * 32 + 8 * fq;
        const bool samp = u.pm >= 32;
        if (pn < 16 || pn >= 28) {
            bf16_t* base; int ld; int mode;
            if (pn < 8) { base = XR + pn * BM; ld = 2048; mode = 0; }
            else if (pn < 16) { base = GR + (pn - 8) * BM; ld = 2048; mode = 1; }
            else { base = GM + (pn - 28) * BM; ld = 4096; mode = 2; }
            base += (size_t)(u.pm * BM + rl0) * ld + c8;
#define EPIWIN_ROWS(F) _Pragma("unroll") for (int ai = 0; ai < 2; ++ai) _Pragma("unroll") for (int m = 0; m < 4; ++m) { bf16_t* rowp = base + (size_t)(ai * HALF + m * 16) * ld; \
                _Pragma("unroll") for (int bj = 0; bj < 2; ++bj) { const f32x4 v0 = acc[ai][bj][m][0], v1 = acc[ai][bj][m][1]; u32x4 w; \
                    w.x = cvt_pk_bf16(F(v0[0]), F(v0[1])); w.y = cvt_pk_bf16(F(v0[2]), F(v0[3])); w.z = cvt_pk_bf16(F(v1[0]), F(v1[1])); w.w = cvt_pk_bf16(F(v1[2]), F(v1[3])); \
                    *(u32x4*)(rowp + bj * HALF) = w; } }
#define EPIWIN_ID(x) (x)
            if (mode == 0) { EPIWIN_ROWS(EPIWIN_ID) }
            else if (mode == 1) { EPIWIN_ROWS(gelu_tanh) }
            else { EPIWIN_ROWS(sigm) }
#undef EPIWIN_ID
#undef EPIWIN_ROWS
            return;
        }
        int b, t0, kvrow0;
        if (samp) { const int ms0 = (u.pm - 32) * BM; b = ms0 >> 11; t0 = ms0 & 2047; kvrow0 = 8192 + b * 2560 + 512 + t0; }
        else { b = u.pm; t0 = 0; kvrow0 = u.pm * BM; }
        if (pn < 24) {
            const bool isk = pn >= 20; const int cb = (isk ? pn - 20 : pn - 16) * BM + c0;
            bf16_t* dst = isk ? KB + (size_t)(kvrow0 + rl0) * 1024 + cb : Q + (size_t)(u.pm * BM + rl0) * 1024 + cb;
            if (samp) {
                const int axis = wc & 1;
#pragma unroll
                for (int ai = 0; ai < 2; ++ai)
#pragma unroll
                    for (int m = 0; m < 4; ++m) { const int t = t0 + rl0 + ai * HALF + m * 16; const int pos = axis ? (t & 63) : (t >> 6);
                        const f32x4 c4 = *(const f32x4*)(rc + pos * 16 + 4 * fq), s4 = *(const f32x4*)(rs + pos * 16 + 4 * fq);
                        bf16_t* rowp = dst + (size_t)(ai * HALF + m * 16) * 1024;
#pragma unroll
                        for (int bj = 0; bj < 2; ++bj) { const f32x4 x1 = acc[ai][bj][m][0], x2 = acc[ai][bj][m][1];
                            st4bf(rowp + bj * HALF, x1 * c4 - x2 * s4); st4bf(rowp + bj * HALF + 16, x2 * c4 + x1 * s4); }
                        asm volatile("" ::: "memory"); }
            } else {
                float* oc = isk ? ock + ((size_t)b * 512 + rl0) * 1024 + cb : nullptr;
#pragma unroll
                for (int ai = 0; ai < 2; ++ai)
#pragma unroll
                    for (int m = 0; m < 4; ++m) { bf16_t* rowp = dst + (size_t)(ai * HALF + m * 16) * 1024;
#pragma unroll
                        for (int bj = 0; bj < 2; ++bj)
#pragma unroll
                            for (int n = 0; n < 2; ++n) { st4bf(rowp + bj * HALF + n * 16, acc[ai][bj][m][n]);
                                if (isk) *(f32x4*)(oc + (size_t)(ai * HALF + m * 16) * 1024 + bj * HALF + n * 16) = acc[ai][bj][m][n]; } }
            }
        } else {
            const int cb = (pn - 24) * BM + c8;
            bf16_t* dst = VB + (size_t)(kvrow0 + rl0) * 1024 + cb;
            float* oc = ocv + ((size_t)b * 512 + rl0) * 1024 + cb;
#pragma unroll
            for (int ai = 0; ai < 2; ++ai)
#pragma unroll
                for (int m = 0; m < 4; ++m) { bf16_t* rowp = dst + (size_t)(ai * HALF + m * 16) * 1024;
#pragma unroll
                    for (int bj = 0; bj < 2; ++bj) { const f32x4 v0 = acc[ai][bj][m][0], v1 = acc[ai][bj][m][1];
                        u32x4 w; w.x = cvt_pk_bf16(v0[0], v0[1]); w.y = cvt_pk_bf16(v0[2], v0[3]); w.z = cvt_pk_bf16(v1[0], v1[1]); w.w = cvt_pk_bf16(v1[2], v1[3]);
                        *(u32x4*)(rowp + bj * HALF) = w;
                        if (!samp) { float* op = oc + (size_t)(ai * HALF + m * 16) * 1024 + bj * HALF; *(f32x4*)op = v0; *(f32x4*)(op + 4) = v1; } } }
        }
    }
};
typedef _Float16 h16x4e __attribute__((ext_vector_type(4)));
typedef _Float16 h16x8e __attribute__((ext_vector_type(8)));
struct EpiGate1 {
    static constexpr bool PERM = true, AFTER_DRAIN = false; static constexpr int NVM = 32;
    _Float16* U16; const bf16_t* GM;
    __device__ __forceinline__ void operator()(const f32x4 (&acc)[2][2][4][2], const Unit& u, int wr, int wc, int fr, int fq) const {
        const int row0 = u.pm * BM + wr * 64 + fr, col0 = u.pn * BM + wc * 32 + 8 * fq;
        u32x4 g[2][4][2];
#pragma unroll
        for (int ai = 0; ai < 2; ++ai)
#pragma unroll
            for (int m = 0; m < 4; ++m)
#pragma unroll
                for (int bj = 0; bj < 2; ++bj) g[ai][m][bj] = *(const u32x4*)(GM + (size_t)(row0 + ai * HALF + m * 16) * 4096 + col0 + bj * HALF);
#pragma unroll
        for (int ai = 0; ai < 2; ++ai)
#pragma unroll
            for (int m = 0; m < 4; ++m)
#pragma unroll
                for (int bj = 0; bj < 2; ++bj) { const u32x4 q = g[ai][m][bj]; const f32x4 v0 = acc[ai][bj][m][0], v1 = acc[ai][bj][m][1];
                    h16x8e hv;
                    hv[0] = (_Float16)(__uint_as_float(q.x << 16) * v0[0]); hv[1] = (_Float16)(__uint_as_float(q.x & 0xffff0000u) * v0[1]);
                    hv[2] = (_Float16)(__uint_as_float(q.y << 16) * v0[2]); hv[3] = (_Float16)(__uint_as_float(q.y & 0xffff0000u) * v0[3]);
                    hv[4] = (_Float16)(__uint_as_float(q.z << 16) * v1[0]); hv[5] = (_Float16)(__uint_as_float(q.z & 0xffff0000u) * v1[1]);
                    hv[6] = (_Float16)(__uint_as_float(q.w << 16) * v1[2]); hv[7] = (_Float16)(__uint_as_float(q.w & 0xffff0000u) * v1[3]);
                    *(h16x8e*)(U16 + (size_t)(row0 + ai * HALF + m * 16) * 2048 + col0 + bj * HALF) = hv; }
    }
};
struct EpiGate2 {
    static constexpr bool PERM = true, AFTER_DRAIN = false; static constexpr int NVM = 48;
    const _Float16* U16; const bf16_t* GM; bf16_t* U;
    __device__ __forceinline__ void operator()(const f32x4 (&acc)[2][2][4][2], const Unit& u, int wr, int wc, int fr, int fq) const {
        const int row0 = u.pm * BM + wr * 64 + fr, col0 = u.pn * BM + wc * 32 + 8 * fq;
#pragma unroll
        for (int ai = 0; ai < 2; ++ai) {
            u32x4 g[4][2]; h16x8e h[4][2];
#pragma unroll
            for (int m = 0; m < 4; ++m)
#pragma unroll
                for (int bj = 0; bj < 2; ++bj) { const size_t r = (size_t)(row0 + ai * HALF + m * 16);
                    g[m][bj] = *(const u32x4*)(GM + r * 4096 + 2048 + col0 + bj * HALF); h[m][bj] = *(const h16x8e*)(U16 + r * 2048 + col0 + bj * HALF); }
#pragma unroll
            for (int m = 0; m < 4; ++m)
#pragma unroll
                for (int bj = 0; bj < 2; ++bj) { const u32x4 q = g[m][bj]; const h16x8e hv = h[m][bj]; const f32x4 v0 = acc[ai][bj][m][0], v1 = acc[ai][bj][m][1];
                    u32x4 w;
                    w.x = cvt_pk_bf16((float)hv[0] + __uint_as_float(q.x << 16) * v0[0], (float)hv[1] + __uint_as_float(q.x & 0xffff0000u) * v0[1]);
                    w.y = cvt_pk_bf16((float)hv[2] + __uint_as_float(q.y << 16) * v0[2], (float)hv[3] + __uint_as_float(q.y & 0xffff0000u) * v0[3]);
                    w.z = cvt_pk_bf16((float)hv[4] + __uint_as_float(q.z << 16) * v1[0], (float)hv[5] + __uint_as_float(q.z & 0xffff0000u) * v1[1]);
                    w.w = cvt_pk_bf16((float)hv[6] + __uint_as_float(q.w << 16) * v1[2], (float)hv[7] + __uint_as_float(q.w & 0xffff0000u) * v1[3]);
                    *(u32x4*)(U + (size_t)(row0 + ai * HALF + m * 16) * 2048 + col0 + bj * HALF) = w; }
            asm volatile("" ::: "memory");
        }
    }
};
template <class Epi, class Sched, bool ALIGN_EPI = false, bool SP2 = false>
__device__ __forceinline__ void gemm_phase(PG8_LAS unsigned char* lds, const Gemm g, const Sched& S, const Epi& E) {
    const int tid = opaque_tid(), wid = __builtin_amdgcn_readfirstlane(tid >> 6), lane = tid & 63, wr = wid >> 2, wc = wid & 3, fr = lane & 15, fq = lane >> 4;
    const int K = g.K, nt = K / BK;
    unsigned voffA[2], voffB[2];
#pragma unroll
    for (int i = 0; i < 2; ++i) { int R, C; stage_rc(tid * 16 + i * 8192, R, C); const int Rb = Epi::PERM ? ((R & ~31) + perm32(R & 31)) : R;
        voffA[i] = (unsigned)(R * K + C) * 2u; voffB[i] = (unsigned)(Rb * K + C) * 2u; }
    const size_t kstep = (size_t)(BK * 2);
    const size_t hstep = (size_t)HALF * K * 2;
    const size_t tstep = 2 * hstep;
    const unsigned ldsw = (unsigned)wid * 1024u;
    const int aoff = lds_byte(wr * 64 + fr, fq * 8), boff = lds_byte(wc * 32 + fr, fq * 8);
#define PG8_SA(b, h) (((b) * 2 + (h)) * HTB)
#define PG8_SB(b, h) ((4 + (b) * 2 + (h)) * HTB)
#define PG8_STAGE(bufoff, gbase, voff) do { _Pragma("unroll") for (int _i = 0; _i < 2; ++_i) \
        __builtin_amdgcn_global_load_lds((const unsigned*)((const char*)(gbase) + (voff)[_i]), (PG8_LAS unsigned*)(lds + (bufoff) + ldsw + _i * 8192), 16, 0, 0); } while (0)
#define PG8_LDA(dst, b, h) do { _Pragma("unroll") for (int m = 0; m < 4; ++m) _Pragma("unroll") for (int k = 0; k < 2; ++k) dst[m][k] = *(const PG8_LAS bf16x8*)(lds + PG8_SA(b, h) + aoff + m * 2048 + k * 1024); } while (0)
#define PG8_LDB(dst, b, h) do { _Pragma("unroll") for (int n = 0; n < 2; ++n) _Pragma("unroll") for (int k = 0; k < 2; ++k) dst[n][k] = *(const PG8_LAS bf16x8*)(lds + PG8_SB(b, h) + boff + n * 2048 + k * 1024); } while (0)
#define PG8_MMA(ai, bj, At, Bt) do { __builtin_amdgcn_s_setprio(1); _Pragma("unroll") for (int m = 0; m < 4; ++m) _Pragma("unroll") for (int n = 0; n < 2; ++n) _Pragma("unroll") for (int k = 0; k < 2; ++k) \
        acc[ai][bj][m][n] = __builtin_amdgcn_mfma_f32_16x16x32_bf16(Bt[n][k], At[m][k], acc[ai][bj][m][n], 0, 0, 0); __builtin_amdgcn_s_setprio(0); } while (0)
#define PG8_WAIT_V(n) asm volatile("s_waitcnt vmcnt(" #n ")" ::: "memory")
#define PG8_WAIT_L(n) asm volatile("s_waitcnt lgkmcnt(" #n ")" ::: "memory")
#define PG8_WAIT_VR asm volatile("s_waitcnt vmcnt(%0)" :: "n"(8 + Epi::NVM) : "memory")
#define PG8_BAR __builtin_amdgcn_s_barrier()
#define PG8_SCHED __builtin_amdgcn_sched_barrier(0)
    Unit cur, nxt; int ui = 0;
    if (!S.next(0, cur)) return;
    f32x4 acc[2][2][4][2];
#pragma unroll
    for (int a = 0; a < 2; ++a)
#pragma unroll
        for (int b = 0; b < 2; ++b)
#pragma unroll
            for (int m = 0; m < 4; ++m)
#pragma unroll
                for (int n = 0; n < 2; ++n) acc[a][b][m][n] = (f32x4){0.f, 0.f, 0.f, 0.f};
    bf16x8 At[4][2], B0[2][2], B1[2][2];
    const char* cA = (const char*)g.A + (size_t)cur.pm * tstep; const char* cB = (const char*)g.Bt + (size_t)cur.pn * tstep;
    S.a_ready(cur);
    if constexpr (SP2) {
        PG8_STAGE(PG8_SB(0, 0), cB, voffB); PG8_STAGE(PG8_SB(0, 1), cB + hstep, voffB); PG8_STAGE(PG8_SA(0, 0), cA, voffA); PG8_STAGE(PG8_SA(0, 1), cA + hstep, voffA);
        if (wr == 1) PG8_BAR;
        PG8_WAIT_V(2); PG8_BAR;
        PG8_STAGE(PG8_SB(1, 0), cB + kstep, voffB); PG8_STAGE(PG8_SA(1, 0), cA + kstep, voffA); PG8_STAGE(PG8_SB(1, 1), cB + hstep + kstep, voffB);
        PG8_WAIT_V(6); PG8_BAR;
    } else {
        PG8_STAGE(PG8_SB(0, 0), cB, voffB); PG8_STAGE(PG8_SA(0, 0), cA, voffA); PG8_STAGE(PG8_SB(0, 1), cB + hstep, voffB); PG8_STAGE(PG8_SA(0, 1), cA + hstep, voffA);
        if (wr == 1) PG8_BAR;
        PG8_WAIT_V(4); PG8_BAR;
        PG8_STAGE(PG8_SB(1, 0), cB + kstep, voffB); PG8_STAGE(PG8_SA(1, 0), cA + kstep, voffA); PG8_STAGE(PG8_SB(1, 1), cB + hstep + kstep, voffB);
        PG8_WAIT_V(6); PG8_BAR;
    }
    bool relax = false;
    for (;;) {
        const bool has_next = S.next(ui + 1, nxt);
        const char* nA = has_next ? (const char*)g.A + (size_t)nxt.pm * tstep : cA; const char* nB = has_next ? (const char*)g.Bt + (size_t)nxt.pn * tstep : cB;
#pragma unroll
        for (int a = 0; a < 2; ++a)
#pragma unroll
            for (int b = 0; b < 2; ++b)
#pragma unroll
                for (int m = 0; m < 4; ++m)
#pragma unroll
                    for (int n = 0; n < 2; ++n) asm volatile("" : "+v"(acc[a][b][m][n]));
        if constexpr (SP2) {
#define PG8_KITER(t, WVA, STG1) do { \
            const bool last = ((t) == nt - 2); \
            const char* a1 = cA + (size_t)((t) + 1) * kstep;                                           \
            const char* a2 = last ? nA : cA + (size_t)((t) + 2) * kstep; const char* b2 = last ? nB : cB + (size_t)((t) + 2) * kstep;     \
            const char* a3 = a2 + kstep; const char* b3 = b2 + kstep;                                \
            if (last && has_next) S.a_ready(nxt); \
              \
            PG8_LDB(B0, 0, 0); PG8_LDB(B1, 0, 1); PG8_SCHED; PG8_LDA(At, 0, 0); STG1; \
            WVA; PG8_WAIT_L(0); PG8_BAR; PG8_MMA(0, 0, At, B0); PG8_MMA(0, 1, At, B1); PG8_BAR; PG8_SCHED; \
              \
            PG8_LDA(At, 0, 1); PG8_STAGE(PG8_SB(0, 0), b2, voffB); PG8_STAGE(PG8_SB(0, 1), b2 + hstep, voffB); PG8_STAGE(PG8_SA(0, 0), a2, voffA); \
            WVA; PG8_WAIT_L(0); PG8_BAR; PG8_MMA(1, 0, At, B0); PG8_MMA(1, 1, At, B1); PG8_BAR; PG8_SCHED; \
              \
            PG8_LDB(B0, 1, 0); PG8_LDB(B1, 1, 1); PG8_SCHED; PG8_LDA(At, 1, 0); PG8_STAGE(PG8_SA(0, 1), a2 + hstep, voffA); \
            WVA; PG8_WAIT_L(0); PG8_BAR; PG8_MMA(0, 0, At, B0); PG8_MMA(0, 1, At, B1); PG8_BAR; PG8_SCHED; \
              \
            PG8_LDA(At, 1, 1); PG8_STAGE(PG8_SB(1, 0), b3, voffB); PG8_STAGE(PG8_SB(1, 1), b3 + hstep, voffB); PG8_STAGE(PG8_SA(1, 0), a3, voffA); \
            PG8_WAIT_V(8); PG8_WAIT_L(0); PG8_BAR; PG8_MMA(1, 0, At, B0); PG8_MMA(1, 1, At, B1); PG8_BAR; PG8_SCHED; } while (0)
            int t = 0;
            if (relax) { PG8_KITER(0, PG8_WAIT_VR, (void)0); t = 2; }
#pragma unroll 1
            for (; t < nt; t += 2) PG8_KITER(t, PG8_WAIT_V(8), PG8_STAGE(PG8_SA(1, 1), a1 + hstep, voffA));
#undef PG8_KITER
        } else {
        for (int t = 0; t < nt; t += 2) {
            const bool last = (t == nt - 2);
            const char* a1 = cA + (size_t)(t + 1) * kstep;
            const char* a2 = last ? nA : cA + (size_t)(t + 2) * kstep; const char* b2 = last ? nB : cB + (size_t)(t + 2) * kstep;
            const char* a3 = a2 + kstep; const char* b3 = b2 + kstep;
            if (last && has_next) S.a_ready(nxt);
            PG8_LDB(B0, 0, 0); PG8_SCHED; PG8_LDA(At, 0, 0); PG8_STAGE(PG8_SA(1, 1), a1 + hstep, voffA);
            PG8_WAIT_L(8); PG8_BAR; PG8_WAIT_L(0); PG8_MMA(0, 0, At, B0); PG8_BAR; PG8_SCHED;
            PG8_LDB(B1, 0, 1); PG8_STAGE(PG8_SB(0, 0), b2, voffB);
            PG8_BAR; PG8_WAIT_L(0); PG8_MMA(0, 1, At, B1); PG8_BAR;
            PG8_LDA(At, 0, 1); PG8_STAGE(PG8_SA(0, 0), a2, voffA);
            PG8_BAR; PG8_WAIT_L(0); PG8_MMA(1, 0, At, B0); PG8_BAR; PG8_SCHED;
            PG8_STAGE(PG8_SB(0, 1), b2 + hstep, voffB);
            PG8_WAIT_V(6); PG8_BAR; PG8_MMA(1, 1, At, B1); PG8_BAR;
            PG8_LDB(B0, 1, 0); PG8_SCHED; PG8_LDA(At, 1, 0); PG8_STAGE(PG8_SA(0, 1), a2 + hstep, voffA);
            PG8_WAIT_L(8); PG8_BAR; PG8_WAIT_L(0); PG8_MMA(0, 0, At, B0); PG8_BAR; PG8_SCHED;
            PG8_LDB(B1, 1, 1); PG8_STAGE(PG8_SB(1, 0), b3, voffB);
            PG8_BAR; PG8_WAIT_L(0); PG8_MMA(0, 1, At, B1); PG8_BAR;
            PG8_LDA(At, 1, 1); PG8_STAGE(PG8_SA(1, 0), a3, voffA);
            PG8_BAR; PG8_WAIT_L(0); PG8_MMA(1, 0, At, B0); PG8_BAR; PG8_SCHED;
            PG8_STAGE(PG8_SB(1, 1), b3 + hstep, voffB);
            PG8_WAIT_V(6); PG8_BAR; PG8_MMA(1, 1, At, B1); PG8_BAR;
        }
        }
        if constexpr (ALIGN_EPI) { if (wr == 0) PG8_BAR; }
        if constexpr (SP2 && !Epi::AFTER_DRAIN) { if (has_next) { PG8_STAGE(PG8_SA(1, 1), nA + kstep + hstep, voffA); relax = true; } }
        if constexpr (!Epi::AFTER_DRAIN) {
            const int tz = opaque_tid(), widz = __builtin_amdgcn_readfirstlane(tz >> 6), lanez = tz & 63, wrz = widz >> 2, wcz = widz & 3, frz = lanez & 15, fqz = lanez >> 4;
            E(acc, cur, wrz, wcz, frz, fqz);
#if defined(REP_EPI)
            if constexpr (Epi::PERM) { asm volatile("" ::: "memory"); E(acc, cur, wrz, wcz, frz, fqz); }
#endif
            S.done(cur); }
        if (!has_next) break;
#pragma unroll
        for (int a = 0; a < 2; ++a)
#pragma unroll
            for (int b = 0; b < 2; ++b)
#pragma unroll
                for (int m = 0; m < 4; ++m)
#pragma unroll
                    for (int n = 0; n < 2; ++n) acc[a][b][m][n] = (f32x4){0.f, 0.f, 0.f, 0.f};
        cur = nxt; cA = nA; cB = nB; ++ui;
        if constexpr (ALIGN_EPI) { if (wr == 1) PG8_BAR; }
    }
    PG8_WAIT_V(0);
    if constexpr (!ALIGN_EPI) { if (wr == 0) PG8_BAR; }
    PG8_BAR;
    if constexpr (Epi::AFTER_DRAIN) { E.fused(acc, cur, wr, wc, fr, fq, lds, wid, lane); S.done(cur); }
#undef PG8_SA
#undef PG8_SB
#undef PG8_STAGE
#undef PG8_LDA
#undef PG8_LDB
#undef PG8_MMA
#undef PG8_WAIT_V
#undef PG8_WAIT_L
#undef PG8_WAIT_VR
#undef PG8_BAR
#undef PG8_SCHED
}
}
#define GAS __attribute__((address_space(1)))
#define LAS __attribute__((address_space(3)))
typedef unsigned short bf16;
typedef unsigned v4u __attribute__((ext_vector_type(4)));
typedef float f32x4 __attribute__((ext_vector_type(4)));
typedef short bf16x8 __attribute__((ext_vector_type(8)));
typedef GAS unsigned gu32;
typedef GAS unsigned long long gu64;
#define RLX_AGENT __ATOMIC_RELAXED, __HIP_MEMORY_SCOPE_AGENT
#define LDS_WAIT() asm volatile("s_waitcnt lgkmcnt(0)" ::: "memory")
#define VM_WAIT() asm volatile("s_waitcnt vmcnt(0)" ::: "memory")
__device__ __forceinline__ unsigned long long rt() { return __builtin_amdgcn_s_memrealtime(); }
__device__ __forceinline__ unsigned f2bf(float f) { unsigned u = __builtin_bit_cast(unsigned, f); return (u + 0x7fffu + ((u >> 16) & 1u)) >> 16; }
__device__ __forceinline__ unsigned pk2(float lo, float hi) { return f2bf(lo) | (f2bf(hi) << 16); }
#define XB_TMO      128
#define XB_XCNT(j)  (256  + 64 * (j))
#define XB_XSUB(j)  (1280 + 64 * (j))
#define XB_XGEN(j)  (2304 + 64 * (j))
#define XB_TOP      3328
#define XB_TOPGEN   3392
#define XCD_BAR_WORDS 3456
#define XB_SPIN_CAP (1u << 18)

__device__ __forceinline__ unsigned xb_ld(unsigned* p)              { return __hip_atomic_load(p, __ATOMIC_RELAXED, __HIP_MEMORY_SCOPE_AGENT); }
__device__ __forceinline__ unsigned xb_add(unsigned* p, unsigned v) { return __hip_atomic_fetch_add(p, v, __ATOMIC_RELAXED, __HIP_MEMORY_SCOPE_AGENT); }
__device__ __forceinline__ unsigned xb_xcc_id() { return (unsigned)__builtin_amdgcn_s_getreg((3 << 11) | 20) & 0xFu; }
#define XB_SPIN(cond, bar) do { unsigned _sp = 0; while (cond) { __builtin_amdgcn_s_sleep(1); \
    if ((++_sp & 255u) == 0u) { if (xb_ld(&(bar)[XB_TMO])) break; if (_sp > XB_SPIN_CAP) { atomicAdd(&(bar)[XB_TMO], 1u); break; } } } } while (0)

struct XcdBarrier {
    unsigned* bar; unsigned x;
    volatile LAS unsigned* st;
};

__device__ __forceinline__ XcdBarrier xcd_barrier_post(unsigned* bar, volatile LAS unsigned* st) {
    XcdBarrier b; b.bar = bar; b.x = xb_xcc_id(); b.st = st;
    if (threadIdx.x == 0) (void)xb_add(&bar[XB_XCNT(b.x)], 1u);
    return b;
}
__device__ __forceinline__ void xcd_barrier_complete(unsigned* bar, unsigned x, unsigned& nloc, unsigned& nx) {
    const unsigned G = gridDim.x * gridDim.y * gridDim.z;
    unsigned sum, cnt, mine, sp = 0u;
    for (;;) {
        sum = 0u; cnt = 0u; mine = 0u;
#pragma unroll
        for (unsigned j = 0; j < 16; ++j) { const unsigned c = xb_ld(&bar[XB_XCNT(j)]); sum += c; cnt += (c > 0u) ? 1u : 0u; mine = (j == x) ? c : mine; }
        if (sum == G) break;
        __builtin_amdgcn_s_sleep(1);
        if ((++sp & 255u) == 0u) { if (xb_ld(&bar[XB_TMO])) break; if (sp > XB_SPIN_CAP) { atomicAdd(&bar[XB_TMO], 1u); break; } }
    }
    nloc = mine > 0u ? mine : 1u; nx = cnt > 0u ? cnt : 1u;
}

__device__ __forceinline__ void xcd_barrier(const XcdBarrier& b) {
    asm volatile("s_waitcnt vmcnt(0)" ::: "memory");
    __syncthreads();
    if (threadIdx.x == 0) {
        unsigned* bar = b.bar;
        __builtin_amdgcn_s_waitcnt(0);
        unsigned nloc = b.st[0], nx = b.st[1];
        if (nloc == 0u) { xcd_barrier_complete(bar, b.x, nloc, nx); b.st[0] = nloc; b.st[1] = nx; }
        const unsigned old = xb_add(&bar[XB_XSUB(b.x)], 1u);
        const unsigned gen = old / nloc;
        if (old + 1u == (gen + 1u) * nloc) {
            __builtin_amdgcn_fence(__ATOMIC_RELEASE, "agent");
            asm volatile("s_waitcnt vmcnt(0)" ::: "memory");
            const unsigned og = xb_add(&bar[XB_TOP], 1u);
            const unsigned tg = og / nx;
            if (og + 1u == (tg + 1u) * nx) xb_add(&bar[XB_TOPGEN], 1u);
            else XB_SPIN(xb_ld(&bar[XB_TOPGEN]) == tg, bar);
            __builtin_amdgcn_fence(__ATOMIC_ACQUIRE, "agent");
            xb_add(&bar[XB_XGEN(b.x)], 1u);
            asm volatile("s_waitcnt vmcnt(0)" ::: "memory");
        } else {
            XB_SPIN(xb_ld(&bar[XB_XGEN(b.x)]) == gen, bar);
            __builtin_amdgcn_fence(__ATOMIC_ACQUIRE, "agent");
            asm volatile("s_waitcnt vmcnt(0)" ::: "memory");
        }
    }
    __syncthreads();
}

constexpr int DM = 2048, DFF = 5504, NFF2 = 11008, NIN = 11264, NMODC = 18432;
constexpr int MC = 8192, MS = 16384, M = 24576, TCX = 256, TSM = 2048, PAST = 512, KVS = 2560;
constexpr int KVROWS = MC + 8 * KVS;
constexpr float NORM_EPS = 1e-6f;
constexpr int NPHASE = 27;
constexpr int NWAVES = 8;

constexpr size_t MiB = 1u << 20;
constexpr size_t WS_CTL = 0, CTL_ZERO_BYTES = 1 * MiB;
constexpr size_t WS_MODP = 1 * MiB;
constexpr size_t WS_MOD = 22 * MiB;
constexpr size_t WS_ROPE = 24 * MiB;
constexpr size_t WS_W1T = 25 * MiB;
constexpr size_t WS_W2T = 111 * MiB;
constexpr size_t WS_WINT = 154 * MiB;
constexpr size_t WS_PLRUT = 198 * MiB;
constexpr size_t WS_PATTNT = 206 * MiB;
constexpr size_t WS_WOUTT = 210 * MiB;
constexpr size_t WS_WG = 218 * MiB;
constexpr size_t WS_KB = 220 * MiB;
constexpr size_t WS_VB = 276 * MiB;
constexpr size_t WS_H = 332 * MiB;
constexpr size_t WS_R1 = 428 * MiB;
constexpr size_t WS_R2 = 686 * MiB;
constexpr size_t WS_GM = 878 * MiB;
constexpr size_t WS_HF = 1070 * MiB;
constexpr size_t WS_HB = 1166 * MiB;
constexpr size_t WS_X16 = 1262 * MiB;
constexpr size_t WS_END = 1358 * MiB;
constexpr int CW_BAR = 4096;

constexpr int RING_BYTES = 131072;
constexpr int LDSCTL_OFF = RING_BYTES, MISC_OFF = LDSCTL_OFF + 320;
constexpr int LDS_BYTES = 147456;
constexpr int PTAB_OFF = LDSCTL_OFF + 1024;

typedef _Float16 h16x4 __attribute__((ext_vector_type(4)));
__device__ __forceinline__ float wave_sum(float v) {
#pragma unroll
    for (int o = 1; o < 64; o <<= 1) v += __shfl_xor(v, o);
    return v;
}
__device__ __forceinline__ unsigned cvtpk(float lo, float hi) { return pg8::cvt_pk_bf16(lo, hi); }
__device__ __forceinline__ float bflo(unsigned w) { return __uint_as_float(w << 16); }
__device__ __forceinline__ float bfhi(unsigned w) { return __uint_as_float(w & 0xffff0000u); }

struct Ptrs {
    const volatile LAS unsigned* tab; float* out; unsigned char* ws;
    __device__ __forceinline__ const float* in(int i) const { const unsigned lo = (unsigned)__builtin_amdgcn_readfirstlane((int)tab[2 * i]), hi = (unsigned)__builtin_amdgcn_readfirstlane((int)tab[2 * i + 1]);
        return (const float*)(const GAS float*)(((unsigned long long)hi << 32) | lo); }
};
struct CwItem { const float* src; bf16* dst; int N, K, k0, n0, drow0, pm; };
__device__ __forceinline__ CwItem cw_decode(const Ptrs& P, int l, int it) {
    bf16* W1T = (bf16*)(P.ws + WS_W1T); bf16* W2T = (bf16*)(P.ws + WS_W2T); bf16* WINT = (bf16*)(P.ws + WS_WINT);
    bf16* PLT = (bf16*)(P.ws + WS_PLRUT); bf16* PAT = (bf16*)(P.ws + WS_PATTNT); bf16* WOT = (bf16*)(P.ws + WS_WOUTT); bf16* WG = (bf16*)(P.ws + WS_WG);
    constexpr int I_W1 = 2 * 32 * 344, I_W2 = 2 * 86 * 64, I_WIN = 32 * 352, I_PL = 32 * 64, I_PA = 16 * 64, I_WO = 32 * 64;
    CwItem c; int r = it; c.pm = 0;
    if (r < I_W1) { const int f = r / 11008, r2 = r % 11008, kb = r2 / 344, nb = r2 % 344, n0 = 32 * nb, isu = n0 / DFF, j0 = n0 % DFF;
        c.src = P.in(11) + (size_t)(l * 2 + f) * DM * NFF2; c.N = NFF2; c.k0 = 64 * kb; c.n0 = n0; c.dst = W1T + (size_t)f * NFF2 * DM; c.K = DM; c.drow0 = (j0 >> 7) * 256 + isu * 128 + (j0 & 127); return c; }
    r -= I_W1;
    if (r < I_W2) { const int f = r / 5504, r2 = r % 5504, kb = r2 / 64, nb = r2 % 64;
        c.src = P.in(12) + (size_t)(l * 2 + f) * DFF * DM; c.N = DM; c.k0 = 64 * kb; c.n0 = 32 * nb; c.dst = W2T + (size_t)f * DM * DFF; c.K = DFF; c.drow0 = 32 * nb; return c; }
    r -= I_W2;
    if (r < I_WIN) { const int kb = r / 352, nb = r % 352;
        c.src = P.in(13) + (size_t)l * DM * NIN; c.N = NIN; c.k0 = 64 * kb; c.n0 = 32 * nb; c.dst = WINT; c.K = DM; c.drow0 = 32 * nb; c.pm = (nb >= 128 && nb < 192) ? 1 : 0; return c; }
    r -= I_WIN;
    if (r < I_PL) { const int kb = r / 64, nb = r % 64;
        c.src = P.in(26) + (size_t)l * DM * DM; c.N = DM; c.k0 = 64 * kb; c.n0 = 32 * nb; c.dst = PLT; c.K = DM; c.drow0 = 32 * nb; return c; }
    r -= I_PL;
    if (r < I_PA) { const int kb = r / 64, nb = r % 64;
        c.src = P.in(27) + (size_t)l * 1024 * DM; c.N = DM; c.k0 = 64 * kb; c.n0 = 32 * nb; c.dst = PAT; c.K = 1024; c.drow0 = 32 * nb; return c; }
    r -= I_PA;
    if (r < I_WO) { const int kb = r / 64, nb = r % 64;
        c.src = P.in(28) + (size_t)l * DM * DM; c.N = DM; c.k0 = 64 * kb; c.n0 = 32 * nb; c.dst = WOT; c.K = DM; c.drow0 = 32 * nb; return c; }
    r -= I_WO;
    { const int mat = r >> 7, g = mat >> 1, dir = mat & 1, r2 = r & 127, n = r2 >> 3, r3 = r2 & 7, kb = r3 >> 2, nb = r3 & 3;
      c.src = (g ? P.in(18) : P.in(16)) + (size_t)((l * 2 + dir) * 16 + n) * 16384; c.N = 128; c.k0 = 64 * kb; c.n0 = 32 * nb; c.dst = WG + (size_t)((n * 2 + dir) * 2 + g) * 16384; c.K = 128; c.drow0 = 32 * nb; }
    return c;
}
constexpr int CW_NIT = 2 * 32 * 344 + 2 * 86 * 64 + 32 * 352 + 32 * 64 + 16 * 64 + 32 * 64 + 512;
__device__ __forceinline__ void convert_weights(const Ptrs& P, int l, LAS unsigned char* lds, int it0, int stride, int itend, int wave, int lane) {
    LAS float* scr = (LAS float*)(lds + wave * 16384);
    const int gw = it0, NGW = stride, NIT = itend;
    if (gw >= NIT) return;
    f32x4 tva[8], tvb[8];
#define CW_LOAD(tv_, c_) do { _Pragma("unroll") for (int i_ = 0; i_ < 8; ++i_) tv_[i_] = *(const GAS f32x4*)((c_).src + (size_t)((c_).k0 + 8 * i_ + (lane >> 3)) * (c_).N + (c_).n0 + 4 * (lane & 7)); } while (0)
#define CW_ITEM(tv_, cur_, nextit_) do { \
        _Pragma("unroll") for (int i = 0; i < 8; ++i) { LAS float* d = scr + (8 * i + (lane >> 3)) * 33 + 4 * (lane & 7); d[0] = tv_[i][0]; d[1] = tv_[i][1]; d[2] = tv_[i][2]; d[3] = tv_[i][3]; } \
        LDS_WAIT(); asm volatile("" ::: "memory"); \
        const CwItem done = cur_; \
        if ((nextit_) < NIT) { cur_ = cw_decode(P, l, (nextit_)); CW_LOAD(tv_, cur_); }       \
        const int c = lane & 7; \
        _Pragma("unroll") for (int j = 0; j < 4; ++j) { const int n = (lane >> 3) + 8 * j; const LAS float* sp = scr + (8 * c) * 33 + n; \
            v4u o; o.x = cvtpk(sp[0 * 33], sp[1 * 33]); o.y = cvtpk(sp[2 * 33], sp[3 * 33]); o.z = cvtpk(sp[4 * 33], sp[5 * 33]); o.w = cvtpk(sp[6 * 33], sp[7 * 33]); \
            *(GAS v4u*)(done.dst + (size_t)(done.drow0 + (done.pm ? pg8::perm32(n) : n)) * done.K + done.k0 + 8 * c) = o; } \
        LDS_WAIT(); asm volatile("" ::: "memory"); } while (0)
    CwItem cura = cw_decode(P, l, gw), curb = cura;
    CW_LOAD(tva, cura);
    if (gw + NGW < NIT) { curb = cw_decode(P, l, gw + NGW); CW_LOAD(tvb, curb); }
    for (int it = gw; it < NIT; it += 2 * NGW) {
        CW_ITEM(tva, cura, it + 2 * NGW);
        if (it + NGW < NIT) CW_ITEM(tvb, curb, it + 3 * NGW);
    }
#undef CW_ITEM
#undef CW_LOAD
}
__device__ __forceinline__ void mod_partials(const Ptrs& P, LAS unsigned char* lds, int gw, int NGW, int wave, int lane) {
    LAS float* scr = (LAS float*)(lds + wave * 16384);
    float* modp = (float*)(P.ws + WS_MODP);
    const float* cvec = P.in(2); const float* cctx = P.in(6); const float* wmod = P.in(7);
    for (int it = gw; it < 2 * 72 * 16; it += NGW) {
        const int kc = it & 15, rest = it >> 4, nb = rest % 72, l = rest / 72, k0 = kc * 128;
        for (int idx = lane; idx < 128 * 9; idx += 64) { const int k = idx / 9, r = idx - 9 * k;
            const float x = (r == 0) ? cctx[k0 + k] : cvec[(r - 1) * DM + k0 + k]; scr[k * 12 + r] = x / (1.0f + expf(-x)); }
        LDS_WAIT(); asm volatile("" ::: "memory");
        const GAS f32x4* wp = (const GAS f32x4*)(wmod + ((size_t)l * DM + k0) * NMODC + nb * 256) + lane;
        f32x4 acc[9];
#pragma unroll
        for (int r = 0; r < 9; ++r) acc[r] = (f32x4){0.f, 0.f, 0.f, 0.f};
#pragma unroll 1
        for (int kg = 0; kg < 128; kg += 16) {
            f32x4 w16[16];
#pragma unroll
            for (int j = 0; j < 16; ++j) w16[j] = wp[(size_t)(kg + j) * (NMODC / 4)];
#pragma unroll
            for (int j = 0; j < 16; ++j) { const int k = kg + j; const f32x4 w = w16[j];
                const f32x4 s0 = *(const LAS f32x4*)(scr + k * 12), s1 = *(const LAS f32x4*)(scr + k * 12 + 4); const float s2 = scr[k * 12 + 8];
                acc[0] += w * s0[0]; acc[1] += w * s0[1]; acc[2] += w * s0[2]; acc[3] += w * s0[3];
                acc[4] += w * s1[0]; acc[5] += w * s1[1]; acc[6] += w * s1[2]; acc[7] += w * s1[3]; acc[8] += w * s2; }
        }
#pragma unroll
        for (int r = 0; r < 9; ++r) *(GAS f32x4*)(modp + ((size_t)(kc * 2 + l) * 9 + r) * NMODC + nb * 256 + 4 * lane) = acc[r];
        LDS_WAIT(); asm volatile("" ::: "memory");
    }
}
__device__ __forceinline__ void mod_reduce(const Ptrs& P, int gtid, int NT) {
    const float* modp = (const float*)(P.ws + WS_MODP); float* mod = (float*)(P.ws + WS_MOD); const float* bmod = P.in(8);
    for (int i = gtid; i < 2 * 9 * (NMODC / 4); i += NT) {
        const int n4 = i % (NMODC / 4), lr = i / (NMODC / 4), l = lr / 9;
        f32x4 s = *(const GAS f32x4*)(bmod + (size_t)l * NMODC + 4 * n4);
#pragma unroll
        for (int kc = 0; kc < 16; ++kc) s += *(const GAS f32x4*)(modp + ((size_t)kc * 18 + lr) * NMODC + 4 * n4);
        *(GAS f32x4*)(mod + (size_t)lr * NMODC + 4 * n4) = s;
    }
}
__device__ __forceinline__ void convert_cache(const Ptrs& P, int l, int gtid, int NT) {
    bf16* KB = (bf16*)(P.ws + WS_KB); bf16* VB = (bf16*)(P.ws + WS_VB);
    for (int i0 = gtid; i0 < 2 * 4096 * 128; i0 += 4 * NT) {
        f32x4 a[4], c[4];
#pragma unroll
        for (int k = 0; k < 4; ++k) { const int i = i0 + k * NT; a[k] = (f32x4){0.f, 0.f, 0.f, 0.f}; c[k] = a[k];
            if (i < 2 * 4096 * 128) { const int tens = i >> 19, j = i & ((1 << 19) - 1), row = j >> 7, ch = j & 127, b = row >> 9, p = row & 511;
                const float* src = (tens ? P.in(4) : P.in(3)) + ((size_t)(b * 2 + l) * 512 + p) * 1024 + ch * 8;
                a[k] = *(const GAS f32x4*)src; c[k] = *(const GAS f32x4*)(src + 4); } }
#pragma unroll
        for (int k = 0; k < 4; ++k) { const int i = i0 + k * NT;
            if (i < 2 * 4096 * 128) { const int tens = i >> 19, j = i & ((1 << 19) - 1), row = j >> 7, ch = j & 127, b = row >> 9, p = row & 511;
                bf16* dst = (tens ? VB : KB) + (size_t)(MC + b * KVS + p) * 1024 + ch * 8;
                v4u o; o.x = cvtpk(a[k][0], a[k][1]); o.y = cvtpk(a[k][2], a[k][3]); o.z = cvtpk(c[k][0], c[k][1]); o.w = cvtpk(c[k][2], c[k][3]);
                *(GAS v4u*)dst = o; } }
    }
}

__device__ __forceinline__ void thin_phase(LAS unsigned char* lds, int bid, int tid, int lane, int wave, int G,
                                           const float* xsrc_c, const float* xsrc_s, const _Float16* X16in, _Float16* X16out, float* Xf32out, const bf16* D, bf16* H,
                                           const float* gpost, const float* mod_res, int gt_chunk, float gscale, bool has_res,
                                           const float* gpre, const float* mod_next, int sc_chunk, int sh_chunk, bool has_next) {
    LAS f32x4* v1 = (LAS f32x4*)lds; LAS f32x4* v2 = (LAS f32x4*)(lds + 8192); LAS f32x4* v3 = (LAS f32x4*)(lds + 16384);
    for (int c = bid; c < M / 32; c += G) {
        const int r = (c < 256) ? 0 : 1 + ((c - 256) >> 6);
        __syncthreads();
        {
            f32x4 a = (f32x4){0.f, 0.f, 0.f, 0.f}, b2 = a, b3 = a;
            if (has_res) { a = *(const GAS f32x4*)(mod_res + (size_t)r * NMODC + gt_chunk * DM + 4 * tid) * *(const GAS f32x4*)(gpost + 4 * tid) * gscale; }
            if (has_next) { b2 = *(const GAS f32x4*)(gpre + 4 * tid) * (*(const GAS f32x4*)(mod_next + (size_t)r * NMODC + sc_chunk * DM + 4 * tid) + 1.0f);
                            b3 = *(const GAS f32x4*)(mod_next + (size_t)r * NMODC + sh_chunk * DM + 4 * tid); }
            v1[tid] = a; v2[tid] = b2; v3[tid] = b3;
        }
        __syncthreads();
        h16x4 xr[8]; unsigned long long dr[8]; f32x4 xf[8];
#define THIN_LOAD(m_) do { if (X16in) { _Pragma("unroll") for (int j_ = 0; j_ < 8; ++j_) xr[j_] = *((const GAS h16x4*)(X16in + (size_t)(m_) * DM) + lane + 64 * j_); } \
            else { const float* xrow_ = ((m_) < MC) ? xsrc_c + (size_t)(m_) * DM : xsrc_s + (size_t)((m_) - MC) * DM; _Pragma("unroll") for (int j_ = 0; j_ < 8; ++j_) xf[j_] = *((const GAS f32x4*)xrow_ + lane + 64 * j_); } \
            if (has_res) { _Pragma("unroll") for (int j_ = 0; j_ < 8; ++j_) dr[j_] = *((const GAS unsigned long long*)(D + (size_t)(m_) * DM) + lane + 64 * j_); } } while (0)
        THIN_LOAD(c * 32 + wave * 4);
#pragma unroll 1
        for (int i = 0; i < 4; ++i) {
            const int m = c * 32 + wave * 4 + i;
            f32x4 x[8], d[8];
            if (X16in) {
#pragma unroll
                for (int j = 0; j < 8; ++j) x[j] = (f32x4){(float)xr[j][0], (float)xr[j][1], (float)xr[j][2], (float)xr[j][3]};
            } else {
#pragma unroll
                for (int j = 0; j < 8; ++j) x[j] = xf[j];
            }
            if (has_res) {
#pragma unroll
                for (int j = 0; j < 8; ++j) { const unsigned long long dw = dr[j]; d[j][0] = bflo((unsigned)dw); d[j][1] = bfhi((unsigned)dw); d[j][2] = bflo((unsigned)(dw >> 32)); d[j][3] = bfhi((unsigned)(dw >> 32)); }
            }
            asm volatile("" ::: "memory");
            if (i < 3) THIN_LOAD(m + 1);
            if (has_res) {
                float s = 0.f;
#pragma unroll
                for (int j = 0; j < 8; ++j) s += (d[j][0] * d[j][0] + d[j][1] * d[j][1]) + (d[j][2] * d[j][2] + d[j][3] * d[j][3]);
                const float rstd = 1.0f / sqrtf(wave_sum(s) * (1.0f / DM) + NORM_EPS);
#pragma unroll
                for (int j = 0; j < 8; ++j) x[j] += v1[lane + 64 * j] * d[j] * rstd;
            }
            if (Xf32out) {
#pragma unroll
                for (int j = 0; j < 8; ++j) *((GAS f32x4*)(Xf32out + (size_t)m * DM) + lane + 64 * j) = x[j];
            } else {
#pragma unroll
                for (int j = 0; j < 8; ++j) { h16x4 hv; hv[0] = (_Float16)x[j][0]; hv[1] = (_Float16)x[j][1]; hv[2] = (_Float16)x[j][2]; hv[3] = (_Float16)x[j][3]; *((GAS h16x4*)(X16out + (size_t)m * DM) + lane + 64 * j) = hv; }
            }
            if (has_next) {
                float s = 0.f;
#pragma unroll
                for (int j = 0; j < 8; ++j) s += (x[j][0] * x[j][0] + x[j][1] * x[j][1]) + (x[j][2] * x[j][2] + x[j][3] * x[j][3]);
                const float rstd = 1.0f / sqrtf(wave_sum(s) * (1.0f / DM) + NORM_EPS);
#pragma unroll
                for (int j = 0; j < 8; ++j) { const f32x4 h = x[j] * rstd * v2[lane + 64 * j] + v3[lane + 64 * j];
                    *((GAS unsigned long long*)(H + (size_t)m * DM) + lane + 64 * j) = (unsigned long long)cvtpk(h[0], h[1]) | ((unsigned long long)cvtpk(h[2], h[3]) << 32); }
            }
        }
    }
#undef THIN_LOAD
    __syncthreads();
}

constexpr int LR_XS = 0, LR_XS_STRIDE = 272, LR_YB = 18688, LR_YB_STRIDE = 272, LR_Y32 = LR_YB + 17408, LR_F_STRIDE = 132  , LR_AS = LR_Y32 + 33792, LR_SEG = LR_AS + 33792, LR_HC = LR_SEG + 4096, LR_CW = LR_HC + 1024  , LR_END = LR_CW + 2560;
static_assert(LR_END <= RING_BYTES, "lru lds");
template <int MODE>
__device__ __forceinline__ void lru_phase(const Ptrs& P, int l, LAS unsigned char* lds, int bid, int tid, int lane, int wave, int G) {
    const bf16* XR = (const bf16*)(P.ws + WS_R1);
    const bf16* HBin = (const bf16*)(P.ws + WS_HB); const bf16* GG = (const bf16*)(P.ws + WS_R1 + 96 * MiB);
    const bf16* WG = (const bf16*)(P.ws + WS_WG);
    float* ostate = P.out + (size_t)M * DM + 4 * (size_t)MC * 1024;
    const int fr = lane & 15, fq = lane >> 4;
    const int nun = (G == 256) ? (bid < 128 ? 1 : 4) : 0;
    for (int ui = 0; ui < nun; ++ui) {
        int b, n, T, row0; bool samp; const int dir = (MODE == 1) ? 1 : 0;
        if (bid < 128) { samp = true; b = bid >> 4; n = bid & 15; T = TSM; row0 = MC + b * TSM; }
        else { const int uc = (bid - 128) * 4 + ui; samp = false; b = uc >> 4; n = uc & 15; T = TCX; row0 = b * TCX; }
        bf16* HO = (bf16*)(P.ws + (MODE == 1 ? WS_HB : WS_HF));
        const int ch0 = n * 128;
        pg8::bf16x8 wf[2][4];
        { const bf16* wb = WG + (size_t)((n * 2 + dir) * 2) * 16384;
#pragma unroll
          for (int g = 0; g < 2; ++g)
#pragma unroll
              for (int ks = 0; ks < 4; ++ks) wf[g][ks] = *(const GAS pg8::bf16x8*)(wb + (size_t)(g * 128 + wave * 16 + fr) * 128 + ks * 32 + fq * 8); }
        const int cch = ch0 + wave * 16 + fr;
        const float ba1 = P.in(17)[(size_t)(l * 2 + dir) * DM + cch] * -1.4426950408889634f, bx1 = P.in(19)[(size_t)(l * 2 + dir) * DM + cch] * -1.4426950408889634f;
        const float sp1 = -8.0f * 1.4426950408889634f * log1pf(expf(-P.in(20)[(size_t)(l * 2 + dir) * DM + cch]));
        float Hc = samp ? P.in(5)[(size_t)((b * 2 + l) * 2 + dir) * DM + cch] : 0.f;
        const int pos = dir ? 3 - fq : fq;
        const int la4 = lane * 4, prev1 = ((lane + (dir ? 16 : -16)) & 63) * 4, prev2 = ((lane + (dir ? 32 : -32)) & 63) * 4, totl = ((dir ? 0 : 48) + fr) * 4; (void)la4;
        const int cc = tid & 15;
        const int ntile = T >> 6;
        const int trow = tid >> 4;
        const LAS float* As = (const LAS float*)(lds + LR_AS); LAS float* Aw = (LAS float*)(lds + LR_AS); const LAS float* Ys = (const LAS float*)(lds + LR_Y32);
        v4u xp[3];
#define LRU_TILE(i_) (((dir ? (ntile - 1 - (i_)) : (i_))) << 6)
#define LRU_LOADX(t0_) do { _Pragma("unroll") for (int k_ = 0; k_ < 3; ++k_) { const int idx_ = tid + 512 * k_, t_ = (t0_) - 2 + (idx_ >> 4); xp[k_] = (v4u){0u, 0u, 0u, 0u}; \
        if (idx_ < 1072 && t_ >= 0 && t_ < T) xp[k_] = *(const GAS v4u*)(XR + (size_t)(row0 + t_) * DM + ch0 + (idx_ & 15) * 8); } } while (0)
#define LRU_PUTX() do { asm volatile("s_waitcnt vmcnt(0)" : "+v"(xp[0]), "+v"(xp[1]), "+v"(xp[2]) :: "memory");   \
        _Pragma("unroll") for (int k_ = 0; k_ < 3; ++k_) { const int idx_ = tid + 512 * k_; if (idx_ < 1072) *(LAS v4u*)(lds + LR_XS + (idx_ >> 4) * LR_XS_STRIDE + (idx_ & 15) * 16) = xp[k_]; } } while (0)
        LRU_LOADX(LRU_TILE(0)); LRU_PUTX();
        if (ntile > 1) LRU_LOADX(LRU_TILE(1));
        if (tid < 128) {
            LAS float* cwl = (LAS float*)(lds + LR_CW);
#pragma unroll
            for (int j = 0; j < 4; ++j) cwl[j * 128 + tid] = P.in(14)[(size_t)(l * 4 + j) * DM + ch0 + tid];
            cwl[512 + tid] = P.in(15)[(size_t)l * DM + ch0 + tid]; }
        __syncthreads();
#pragma unroll 1
        for (int it = 0; it < ntile; ++it) {
            const int t0 = LRU_TILE(it);
            v4u hbv[2], ggv[2];
            if (MODE == 2) {
#pragma unroll
                for (int k = 0; k < 2; ++k) { const size_t off = (size_t)(row0 + t0 + trow + 32 * k) * DM + ch0 + cc * 8; hbv[k] = *(const GAS v4u*)(HBin + off); ggv[k] = *(const GAS v4u*)(GG + off); }
            }
            float cw[4][8], cbias[8];
            { const LAS float* cwl = (const LAS float*)(lds + LR_CW) + cc * 8;
#pragma unroll
              for (int j = 0; j < 5; ++j) { const f32x4 a = *(const LAS f32x4*)(cwl + j * 128), c2 = *(const LAS f32x4*)(cwl + j * 128 + 4);
#pragma unroll
                  for (int e = 0; e < 4; ++e) { if (j < 4) { cw[j][e] = a[e]; cw[j][4 + e] = c2[e]; } else { cbias[e] = a[e]; cbias[4 + e] = c2[e]; } } } }
#pragma unroll
            for (int k = 0; k < 2; ++k) { const int tl = trow + 32 * k;
                float y[8];
#pragma unroll
                for (int e = 0; e < 8; ++e) y[e] = cbias[e];
#pragma unroll
                for (int j = 0; j < 4; ++j) { const v4u xv = *(const LAS v4u*)(lds + LR_XS + (tl + j) * LR_XS_STRIDE + cc * 16);
                    y[0] += cw[j][0] * bflo(xv.x); y[1] += cw[j][1] * bfhi(xv.x); y[2] += cw[j][2] * bflo(xv.y); y[3] += cw[j][3] * bfhi(xv.y);
                    y[4] += cw[j][4] * bflo(xv.z); y[5] += cw[j][5] * bfhi(xv.z); y[6] += cw[j][6] * bflo(xv.w); y[7] += cw[j][7] * bfhi(xv.w); }
                v4u o; o.x = cvtpk(y[0], y[1]); o.y = cvtpk(y[2], y[3]); o.z = cvtpk(y[4], y[5]); o.w = cvtpk(y[6], y[7]);
                *(LAS v4u*)(lds + LR_YB + tl * LR_YB_STRIDE + cc * 16) = o;
                LAS float* yf = (LAS float*)(lds + LR_Y32) + tl * LR_F_STRIDE + cc * 8;
                *(LAS f32x4*)yf = (f32x4){y[0], y[1], y[2], y[3]}; *(LAS f32x4*)(yf + 4) = (f32x4){y[4], y[5], y[6], y[7]}; }
            __syncthreads();
            {
                f32x4 ga[4], gx[4];
#pragma unroll
                for (int rb = 0; rb < 4; ++rb) { ga[rb] = (f32x4){0.f, 0.f, 0.f, 0.f}; gx[rb] = ga[rb]; }
#pragma unroll
                for (int kh = 0; kh < 2; ++kh) {
                    pg8::bf16x8 yfr[4][2];
#pragma unroll
                    for (int rb = 0; rb < 4; ++rb)
#pragma unroll
                        for (int k2 = 0; k2 < 2; ++k2) yfr[rb][k2] = *(const LAS pg8::bf16x8*)(lds + LR_YB + (rb * 16 + fr) * LR_YB_STRIDE + ((kh * 2 + k2) * 32 + fq * 8) * 2);
#pragma unroll
                    for (int k2 = 0; k2 < 2; ++k2)
#pragma unroll
                        for (int rb = 0; rb < 4; ++rb) { ga[rb] = __builtin_amdgcn_mfma_f32_16x16x32_bf16(yfr[rb][k2], wf[0][kh * 2 + k2], ga[rb], 0, 0, 0);
                                                         gx[rb] = __builtin_amdgcn_mfma_f32_16x16x32_bf16(yfr[rb][k2], wf[1][kh * 2 + k2], gx[rb], 0, 0, 0); }
                }
                float av[4][4], bv[4][4], SA[4], SB[4];
#pragma unroll
                for (int rb = 0; rb < 4; ++rb) {
#pragma unroll
                    for (int i = 0; i < 4; ++i) { const float yv = Ys[(rb * 16 + fq * 4 + i) * LR_F_STRIDE + wave * 16 + fr];
                        const float gta = __builtin_amdgcn_rcpf(1.0f + __builtin_amdgcn_exp2f(fmaf(ga[rb][i], -1.4426950408889634f, ba1))), gtx = __builtin_amdgcn_rcpf(1.0f + __builtin_amdgcn_exp2f(fmaf(gx[rb][i], -1.4426950408889634f, bx1)));
                        const float a = __builtin_amdgcn_exp2f(gta * sp1); av[rb][i] = a; bv[rb][i] = __builtin_amdgcn_sqrtf(fmaxf(fmaf(-a, a, 1.0f), 0.f)) * gtx * yv; }
                    float A = 1.f, B = 0.f;
#pragma unroll
                    for (int ii = 0; ii < 4; ++ii) { const int i = dir ? 3 - ii : ii; A = av[rb][i] * A; B = fmaf(av[rb][i], B, bv[rb][i]); }
                    SA[rb] = A; SB[rb] = B;
                }
#pragma unroll
                for (int rb = 0; rb < 4; ++rb) { const float pA = __int_as_float(__builtin_amdgcn_ds_bpermute(prev1, __float_as_int(SA[rb]))), pB = __int_as_float(__builtin_amdgcn_ds_bpermute(prev1, __float_as_int(SB[rb])));
                    if (pos >= 1) { SB[rb] = fmaf(SA[rb], pB, SB[rb]); SA[rb] = SA[rb] * pA; } }
#pragma unroll
                for (int rb = 0; rb < 4; ++rb) { const float pA = __int_as_float(__builtin_amdgcn_ds_bpermute(prev2, __float_as_int(SA[rb]))), pB = __int_as_float(__builtin_amdgcn_ds_bpermute(prev2, __float_as_int(SB[rb])));
                    if (pos >= 2) { SB[rb] = fmaf(SA[rb], pB, SB[rb]); SA[rb] = SA[rb] * pA; } }
                float Hin[4], he[4];
                {
                    float TA[4], TB[4];
#pragma unroll
                    for (int rb = 0; rb < 4; ++rb) { TA[rb] = __int_as_float(__builtin_amdgcn_ds_bpermute(totl, __float_as_int(SA[rb]))); TB[rb] = __int_as_float(__builtin_amdgcn_ds_bpermute(totl, __float_as_int(SB[rb]))); }
                    float H = Hc;
#pragma unroll
                    for (int q = 0; q < 4; ++q) { const int rb = dir ? 3 - q : q; Hin[rb] = H; H = fmaf(TA[rb], H, TB[rb]); }
                    Hc = H;
                }
#pragma unroll
                for (int rb = 0; rb < 4; ++rb) he[rb] = fmaf(SA[rb], Hin[rb], SB[rb]);
#pragma unroll
                for (int rb = 0; rb < 4; ++rb) { const float hp = __int_as_float(__builtin_amdgcn_ds_bpermute(prev1, __float_as_int(he[rb])));
                    float h = (pos == 0) ? Hin[rb] : hp;
#pragma unroll
                    for (int ii = 0; ii < 4; ++ii) { const int i = dir ? 3 - ii : ii; h = fmaf(av[rb][i], h, bv[rb][i]); Aw[(rb * 16 + fq * 4 + i) * LR_F_STRIDE + wave * 16 + fr] = h; } }
            }
            if (it + 1 < ntile) { LRU_PUTX(); if (it + 2 < ntile) LRU_LOADX(LRU_TILE(it + 2)); }
            __syncthreads();
            if (MODE == 2) {
                if (it + 1 < ntile) asm volatile("s_waitcnt vmcnt(3)" : "+v"(hbv[0]), "+v"(hbv[1]), "+v"(ggv[0]), "+v"(ggv[1]) :: "memory");
                else asm volatile("s_waitcnt vmcnt(0)" : "+v"(hbv[0]), "+v"(hbv[1]), "+v"(ggv[0]), "+v"(ggv[1]) :: "memory"); }
#pragma unroll
            for (int k = 0; k < 2; ++k) { const int tl = trow + 32 * k; const LAS float* hp = As + tl * LR_F_STRIDE + cc * 8;
                f32x4 a = *(const LAS f32x4*)hp, c2 = *(const LAS f32x4*)(hp + 4);
                if (MODE == 2) { const v4u q = hbv[k], g = ggv[k];
                    a[0] = (a[0] + bflo(q.x)) * bflo(g.x); a[1] = (a[1] + bfhi(q.x)) * bfhi(g.x); a[2] = (a[2] + bflo(q.y)) * bflo(g.y); a[3] = (a[3] + bfhi(q.y)) * bfhi(g.y);
                    c2[0] = (c2[0] + bflo(q.z)) * bflo(g.z); c2[1] = (c2[1] + bfhi(q.z)) * bfhi(g.z); c2[2] = (c2[2] + bflo(q.w)) * bflo(g.w); c2[3] = (c2[3] + bfhi(q.w)) * bfhi(g.w); }
                v4u o; o.x = cvtpk(a[0], a[1]); o.y = cvtpk(a[2], a[3]); o.z = cvtpk(c2[0], c2[1]); o.w = cvtpk(c2[2], c2[3]);
                *(GAS v4u*)(HO + (size_t)(row0 + t0 + tl) * DM + ch0 + cc * 8) = o; }
        }
#undef LRU_LOADX
#undef LRU_PUTX
#undef LRU_TILE
        if (!samp && fq == 0) ostate[(size_t)((b * 2 + l) * 2 + dir) * DM + cch] = Hc;
    }
    __syncthreads();
}

namespace att {
using bf16x8 = __attribute__((ext_vector_type(8))) short;
using s16x4  = __attribute__((ext_vector_type(4))) short;
using f32x16 = __attribute__((ext_vector_type(16))) float;
constexpr int NW = 8, QBLK = 32, KVBLK = 64, LDQ = 1024, LDK = 1024, LDO = 1024;
constexpr float SCALE = 0.125f, THR = 8.f;
constexpr int SHM_V = KVBLK * 128 * 2, SHM_K = KVBLK * 64 * 2, SHM_ATTN = 2 * SHM_V + 2 * SHM_K + NW * 64 * 4, STG_STRIDE = 272, STG_WAVE = 32 * STG_STRIDE;
static_assert(SHM_ATTN + NW * STG_WAVE <= RING_BYTES, "attention LDS");
#define KSWZ64(row, colB) ((row) * 128 + ((colB) ^ ((((row) >> 1) & 7) << 4)))
#define SBAR() __builtin_amdgcn_sched_barrier(0)
__device__ __forceinline__ int crow(int r, int hi) { return (r & 3) + 8 * (r >> 2) + 4 * hi; }
__device__ __forceinline__ void partialSM(f32x16& p0, f32x16& p1, float& m_reg, float& mn, float& alpha) {
  constexpr float C = SCALE * 1.4426950408889634f;
  float pmax = p0[0]; for (int r = 1; r < 16; ++r) pmax = fmaxf(pmax, p0[r]); for (int r = 0; r < 16; ++r) pmax = fmaxf(pmax, p1[r]);
  { auto rr = __builtin_amdgcn_permlane32_swap(__float_as_uint(pmax), __float_as_uint(pmax), false, false);
    pmax = fmaxf(__uint_as_float(rr[0]), __uint_as_float(rr[1])); }
  if (__builtin_expect(__all(pmax - m_reg <= THR / SCALE), 1)) { mn = m_reg; alpha = 1.f; }
  else { mn = fmaxf(m_reg, pmax); alpha = __builtin_amdgcn_exp2f((m_reg - mn) * C); m_reg = mn; }
  float mnC = -mn * C;
  for (int r = 0; r < 16; ++r) p0[r] = fmaf(p0[r], C, mnC); for (int r = 0; r < 16; ++r) p1[r] = fmaf(p1[r], C, mnC);
  for (int r = 0; r < 16; ++r) p0[r] = __builtin_amdgcn_exp2f(p0[r]);
}
__device__ __forceinline__ void finishSM(f32x16& p0, f32x16& p1, float alpha, float& l_reg, bf16x8& pa0, bf16x8& pa1, bf16x8& pa2, bf16x8& pa3) {
  for (int r = 0; r < 16; ++r) p1[r] = __builtin_amdgcn_exp2f(p1[r]);
  float ps = 0; for (int r = 0; r < 16; ++r) ps += p0[r]; for (int r = 0; r < 16; ++r) ps += p1[r];
  { auto rr = __builtin_amdgcn_permlane32_swap(__float_as_uint(ps), __float_as_uint(ps), false, false);
    ps = __uint_as_float(rr[0]) + __uint_as_float(rr[1]); }
  l_reg = l_reg * alpha + ps;
#define PK4(P, BASE, OUT) do { unsigned a0 = cvtpk(P[BASE + 0], P[BASE + 1]), a1 = cvtpk(P[BASE + 2], P[BASE + 3]);   \
    unsigned b0 = cvtpk(P[BASE + 4], P[BASE + 5]), b1 = cvtpk(P[BASE + 6], P[BASE + 7]);                              \
    auto r0 = __builtin_amdgcn_permlane32_swap(a0, b0, false, false); auto r1 = __builtin_amdgcn_permlane32_swap(a1, b1, false, false); \
    v4u w = {r0[0], r1[0], r0[1], r1[1]}; OUT = *reinterpret_cast<bf16x8*>(&w); } while (0)
  PK4(p0, 0, pa0); PK4(p0, 8, pa1); PK4(p1, 0, pa2); PK4(p1, 8, pa3);
#undef PK4
}
__device__ __forceinline__ void qkt(f32x16& p0, f32x16& p1, const char* Ks, const bf16x8* qr, int r32, int hi) {
  p0 = f32x16{}; p1 = f32x16{};
  for (int d0 = 0; d0 < 4; ++d0) { int cb = (d0 * 16 + hi * 8) * 2;
    bf16x8 b0 = *reinterpret_cast<const bf16x8*>(Ks + KSWZ64(r32, cb));
    bf16x8 b1 = *reinterpret_cast<const bf16x8*>(Ks + KSWZ64(32 + r32, cb));
    p0 = __builtin_amdgcn_mfma_f32_32x32x16_bf16(b0, qr[d0], p0, 0, 0, 0);
    p1 = __builtin_amdgcn_mfma_f32_32x32x16_bf16(b1, qr[d0], p1, 0, 0, 0); }
}
__device__ __forceinline__ int v_st(int k, int c) { const int kk = (k & ~0xC) | ((k & 4) << 1) | ((k & 8) >> 1); return ((kk >> 3) * 4 + (c >> 5)) * 512 + ((kk & 7) * 32 + (c & 31)) * 2; }
__device__ __forceinline__ int v_rd_base(int lane) { return ((lane & 3) << 3) | (((lane >> 2) & 3) << 6) | (((lane >> 4) & 1) << 5) | (((lane >> 5) & 1) << 8); }
constexpr int v_rd_off(int d0, int ks, int half) { return d0 * 512 + ks * 4096 + half * 2048; }
template <int OFF> __device__ __forceinline__ s16x4 tr_read(int vb) {
  s16x4 r; asm volatile("ds_read_b64_tr_b16 %0, %1 offset:%2" : "=&v"(r) : "v"(vb), "i"(OFF) : "memory"); return r;
}
template <int D0> __device__ __forceinline__ void pv_one(f32x16& od, int vb, bf16x8 pa0, bf16x8 pa1, bf16x8 pa2, bf16x8 pa3) {
  const s16x4 l0 = tr_read<v_rd_off(D0, 0, 0)>(vb), h0 = tr_read<v_rd_off(D0, 0, 1)>(vb), l1 = tr_read<v_rd_off(D0, 1, 0)>(vb), h1 = tr_read<v_rd_off(D0, 1, 1)>(vb);
  const s16x4 l2 = tr_read<v_rd_off(D0, 2, 0)>(vb), h2 = tr_read<v_rd_off(D0, 2, 1)>(vb), l3 = tr_read<v_rd_off(D0, 3, 0)>(vb), h3 = tr_read<v_rd_off(D0, 3, 1)>(vb);
  asm volatile("s_waitcnt lgkmcnt(0)" ::: "memory"); SBAR();
#define PK(L, H) (bf16x8){L[0], L[1], L[2], L[3], H[0], H[1], H[2], H[3]}
  od = __builtin_amdgcn_mfma_f32_32x32x16_bf16(pa0, PK(l0, h0), od, 0, 0, 0);
  od = __builtin_amdgcn_mfma_f32_32x32x16_bf16(pa1, PK(l1, h1), od, 0, 0, 0);
  od = __builtin_amdgcn_mfma_f32_32x32x16_bf16(pa2, PK(l2, h2), od, 0, 0, 0);
  od = __builtin_amdgcn_mfma_f32_32x32x16_bf16(pa3, PK(l3, h3), od, 0, 0, 0);
#undef PK
}
__device__ __forceinline__ void pv_d0(f32x16* o, int vb, bf16x8 pa0, bf16x8 pa1, bf16x8 pa2, bf16x8 pa3) {
  pv_one<0>(o[0], vb, pa0, pa1, pa2, pa3); pv_one<1>(o[1], vb, pa0, pa1, pa2, pa3); pv_one<2>(o[2], vb, pa0, pa1, pa2, pa3); pv_one<3>(o[3], vb, pa0, pa1, pa2, pa3);
}
template <int FIN>
__device__ __forceinline__ void attn_body(const bf16* __restrict__ Qb, const bf16* __restrict__ Kh, const bf16* __restrict__ Vh, float* __restrict__ Ob, int seq, char* lds,
                                          float lam, const float (&sub)[4], bf16* __restrict__ On) {
  const int tid = opaque_tid(), wid = tid >> 6, lane = tid & 63, r32 = lane & 31, hi = lane >> 5;
  char* V_lds = lds; char* K_lds = lds + 2 * SHM_V;
  float* ws = (float*)(lds + 2 * SHM_V + 2 * SHM_K) + wid * 64; float* li_l = ws; float* al_l = ws + 32;
  float m_reg = -1e30f, l_reg = 0; f32x16 o[4] = {}; bf16x8 qr[4];
  const bf16* Qw = Qb + (long)(wid * QBLK + r32) * LDQ + hi * 8;
#pragma unroll
  for (int d0 = 0; d0 < 4; ++d0) qr[d0] = *reinterpret_cast<const bf16x8*>(Qw + d0 * 16);
  const int sr = tid >> 4, sc = (tid & 15) * 8, vst0 = v_st(sr, sc), vst1 = v_st(32 + sr, sc);
  const int kr = tid >> 3, kc8 = (tid & 7) * 8, kst = KSWZ64(kr, kc8 * 2);
  const int vb0 = (int)(uintptr_t)V_lds + v_rd_base(lane);
  struct { bf16x8 vs0, vs1, ks0; } sr_[2];
#define SLOAD(i, k0) do { sr_[i].vs0 = *reinterpret_cast<const bf16x8*>(&Vh[(long)((k0) + sr) * LDK + sc]); sr_[i].vs1 = *reinterpret_cast<const bf16x8*>(&Vh[(long)((k0) + 32 + sr) * LDK + sc]); \
    sr_[i].ks0 = *reinterpret_cast<const bf16x8*>(&Kh[(long)((k0) + kr) * LDK + kc8]); } while (0)
#define SWRITE(b, i) do { *(bf16x8*)(V_lds + (b) * SHM_V + vst0) = sr_[i].vs0; *(bf16x8*)(V_lds + (b) * SHM_V + vst1) = sr_[i].vs1; \
    *(bf16x8*)(K_lds + (b) * SHM_K + kst) = sr_[i].ks0; } while (0)
#define SWAIT() asm volatile("s_waitcnt vmcnt(3)" ::: "memory")
#define RESC(a) do { if (__any((a) < 1.f)) { if (hi == 0) al_l[r32] = (a); asm volatile("s_waitcnt lgkmcnt(0)" ::: "memory"); \
    for (int d = 0; d < 4; ++d) for (int r = 0; r < 16; ++r) o[d][r] *= al_l[crow(r, hi)]; } } while (0)
  f32x16 pA0, pA1, pB0, pB1; float mnA, mnB, alA, alB; bf16x8 pa0, pa1, pa2, pa3; const int NT = seq / KVBLK;
  constexpr int SE = 0, SO = 1;
  SLOAD(SE, 0); asm volatile("s_waitcnt vmcnt(0)" ::: "memory"); SWRITE(0, SE); __syncthreads();
  qkt(pA0, pA1, K_lds, qr, r32, hi); partialSM(pA0, pA1, m_reg, mnA, alA);
  SLOAD(SO, KVBLK); if (2 < NT) SLOAD(SE, 2 * KVBLK);
  SWAIT(); SWRITE(1, SO); __syncthreads();
  for (int j = 1; j + 1 < NT; j += 2) {
    SBAR(); qkt(pB0, pB1, K_lds + SHM_K, qr, r32, hi);
    finishSM(pA0, pA1, alA, l_reg, pa0, pa1, pa2, pa3); SBAR();
    SLOAD(SO, (j + 2) * KVBLK); SBAR();
    pv_d0(o, vb0, pa0, pa1, pa2, pa3); partialSM(pB0, pB1, m_reg, mnB, alB);
    __syncthreads(); SWAIT(); SWRITE(0, SE);
    RESC(alB); __syncthreads();
    SBAR(); qkt(pA0, pA1, K_lds, qr, r32, hi);
    finishSM(pB0, pB1, alB, l_reg, pa0, pa1, pa2, pa3); SBAR();
    if (j + 3 < NT) SLOAD(SE, (j + 3) * KVBLK); SBAR();
    pv_d0(o, vb0 + (int)SHM_V, pa0, pa1, pa2, pa3); partialSM(pA0, pA1, m_reg, mnA, alA);
    __syncthreads(); SWAIT(); SWRITE(1, SO);
    RESC(alA); __syncthreads();
  }
  SBAR(); qkt(pB0, pB1, K_lds + SHM_K, qr, r32, hi);
  finishSM(pA0, pA1, alA, l_reg, pa0, pa1, pa2, pa3); SBAR();
  pv_d0(o, vb0, pa0, pa1, pa2, pa3); partialSM(pB0, pB1, m_reg, mnB, alB);
  __syncthreads(); RESC(alB);
  finishSM(pB0, pB1, alB, l_reg, pa0, pa1, pa2, pa3); SBAR();
  pv_d0(o, vb0 + (int)SHM_V, pa0, pa1, pa2, pa3);
  if (hi == 0) li_l[r32] = l_reg; asm volatile("s_waitcnt lgkmcnt(0)" ::: "memory");
  float rli[16];
#pragma unroll
  for (int r = 0; r < 16; ++r) rli[r] = __builtin_amdgcn_rcpf(li_l[crow(r, hi)]);
  char* stg = lds + SHM_ATTN + wid * STG_WAVE;
  if (FIN == 0) {
#pragma unroll
    for (int r = 0; r < 16; ++r) { const int orow = crow(r, hi);
#pragma unroll
      for (int d0 = 0; d0 < 4; ++d0) *(unsigned short*)(stg + orow * STG_STRIDE + (d0 * 32 + r32) * 2) = (unsigned short)(cvtpk(o[d0][r] * rli[r], 0.f) & 0xffffu); }
  } else {
#pragma unroll
    for (int r = 0; r < 16; ++r) { const int orow = crow(r, hi);
      float v[4]; float ss = 0.f;
#pragma unroll
      for (int d0 = 0; d0 < 4; ++d0) { const unsigned w0 = *(const unsigned short*)(stg + orow * STG_STRIDE + (d0 * 32 + r32) * 2); v[d0] = __uint_as_float(w0 << 16) - lam * (o[d0][r] * rli[r]); ss += v[d0] * v[d0]; }
      ss += __shfl_xor(ss, 1); ss += __shfl_xor(ss, 2); ss += __shfl_xor(ss, 4); ss += __shfl_xor(ss, 8); ss += __shfl_xor(ss, 16);
      const float rstd = 1.0f / sqrtf(ss * (1.0f / 128.0f) + NORM_EPS);
#pragma unroll
      for (int d0 = 0; d0 < 4; ++d0) *(unsigned short*)(stg + orow * STG_STRIDE + (d0 * 32 + r32) * 2) = (unsigned short)(cvtpk(v[d0] * rstd * sub[d0], 0.f) & 0xffffu); }
    asm volatile("s_waitcnt lgkmcnt(0)" ::: "memory");
    bf16* Onw = On + (long)(wid * QBLK) * LDO;
#pragma unroll
    for (int i = 0; i < 8; ++i) { const int chunk = lane + 64 * i, row = chunk >> 4, c16 = chunk & 15;
      const v4u w = *(const v4u*)(stg + row * STG_STRIDE + c16 * 16); *(v4u*)(Onw + (long)row * LDO + c16 * 8) = w; }
  }
#undef SLOAD
#undef SWRITE
#undef SWAIT
#undef RESC
}
}

template <int PART>
__device__ __forceinline__ void attn_phase(const Ptrs& P, int l, char* lds, int bid, int lane, int G) {
    const bf16* Q = (const bf16*)(P.ws + WS_R1 + 192 * MiB); const bf16* KB = (const bf16*)(P.ws + WS_KB); const bf16* VB = (const bf16*)(P.ws + WS_VB);
    bf16* ON = (bf16*)(P.ws + WS_R2);
    if (G != 256) return;
    int lq = l; asm volatile("" : "+s"(lq));
    const float lam_init = lq == 0 ? 0.2f : 0.35550906759097f;
    const float d1 = wave_sum(P.in(21)[lq * 64 + lane] * P.in(22)[lq * 64 + lane]), d2 = wave_sum(P.in(23)[lq * 64 + lane] * P.in(24)[lq * 64 + lane]);
    const float lam = expf(d1) - expf(d2) + lam_init;
    float sub[4];
#pragma unroll
    for (int d0 = 0; d0 < 4; ++d0) sub[d0] = P.in(25)[lq * 128 + d0 * 32 + (lane & 31)] * (1.0f - lam_init);
    const float nosub[4] = {0.f, 0.f, 0.f, 0.f};
    const int vcu = bid;
    const int nun = (PART == 0) ? (bid >= 128 ? 3 : 1) : 1;
    for (int ui = 0; ui < nun; ++ui) {
        int qrow0, kvrow0, seq, h;
        if (ui == 0) { const int u = vcu + 256 * PART, qb = u & 7; h = (u >> 3) & 7; const int b = u >> 6; qrow0 = MC + b * TSM + qb * 256; kvrow0 = MC + b * KVS; seq = KVS; }
        else { const int r = (bid - 128) * 2 + (ui - 1); h = r & 7; const int b = r >> 3; qrow0 = b * TCX; kvrow0 = qrow0; seq = TCX; }
        const bf16* q0 = Q + (size_t)qrow0 * 1024 + h * 128; const bf16* k0 = KB + (size_t)kvrow0 * 1024 + h * 128; const bf16* v0 = VB + (size_t)kvrow0 * 1024 + h * 128;
        att::attn_body<0>(q0, k0, v0, nullptr, seq, lds, 0.f, nosub, nullptr);
        __syncthreads();
        att::attn_body<1>(q0 + 64, k0 + 64, v0, nullptr, seq, lds, lam, sub, ON + (size_t)qrow0 * 1024 + h * 128);
        __syncthreads();
    }
}

struct Args { const float* in[29]; float* out; unsigned char* ws; int ph_lo, ph_hi; };
__global__ void __launch_bounds__(NWAVES * 64, 2) mega_fwd(Args args) {
    extern __shared__ __attribute__((aligned(16))) unsigned char lds_raw[];
    LAS unsigned char* lds = (LAS unsigned char*)lds_raw;
    volatile LAS unsigned* MISC = (volatile LAS unsigned*)(lds + MISC_OFF);
    const int tid = threadIdx.x, lane = tid & 63, wave = __builtin_amdgcn_readfirstlane(tid >> 6);
    const int bid = (int)blockIdx.x;
    const int G = gridDim.x, gw = blockIdx.x * NWAVES + wave, NGW = G * NWAVES, gtid = blockIdx.x * (NWAVES * 64) + tid, NTH = G * NWAVES * 64;
    Ptrs P; P.tab = (const volatile LAS unsigned*)(lds + PTAB_OFF); P.out = args.out; P.ws = args.ws;
    unsigned char* ws = args.ws;
    for (int u = tid; u < (PTAB_OFF - LDSCTL_OFF) / 4; u += NWAVES * 64) ((LAS unsigned*)(lds + LDSCTL_OFF))[u] = 0u;
    if (tid < 29) { const unsigned long long pv = (unsigned long long)args.in[tid]; ((LAS unsigned*)(lds + PTAB_OFF))[2 * tid] = (unsigned)pv; ((LAS unsigned*)(lds + PTAB_OFF))[2 * tid + 1] = (unsigned)(pv >> 32); }
    __syncthreads();
    XcdBarrier bar = xcd_barrier_post((unsigned*)(ws + WS_CTL) + CW_BAR, MISC + 8);
    const int lo = args.ph_lo, hi = args.ph_hi;
#ifndef SITE_MASK
#define SITE_MASK 0xFFFFFFFFu
#endif
#define EN(s) ((SITE_MASK >> (s)) & 1u)
#ifndef REP_MASK
#define REP_MASK 0u
#endif
#define REPS(s) (((REP_MASK >> (s)) & 1u) ? 2 : 1)
#define IN(k) (lo <= (k) && (k) < hi)
#define SEAM(k) do { if (IN((k) + 1)) xcd_barrier(bar); } while (0)

    float* X = args.out;
    bf16* H = (bf16*)(ws + WS_H);
    bf16* D = (bf16*)(ws + WS_R2);
    const float* MOD = (const float*)(ws + WS_MOD);

    if (EN(0) && IN(0)) {
        mod_partials(P, lds, gw, NGW, wave, lane);
        if (NGW == 2048) { constexpr int C1 = 256 * 15; if (gw < 256) convert_weights(P, 0, lds, gw, 256, C1, wave, lane); else convert_weights(P, 0, lds, C1 + (gw - 256), 1792, CW_NIT, wave, lane); }
        else convert_weights(P, 0, lds, gw, NGW, CW_NIT, wave, lane);
        if (blockIdx.x == 0) { float* rc = (float*)(ws + WS_ROPE); float* rs = rc + 1024;
            for (int i = tid; i < 1024; i += NWAVES * 64) { const int pos = i >> 4, f = i & 15; const float fr = 1.0f / powf(10000.0f, (float)f / 16.0f), ang = (float)pos * fr; rc[i] = cosf(ang); rs[i] = sinf(ang); } }
        SEAM(0);
    }
    if (EN(1) && IN(1)) { mod_reduce(P, gtid, NTH); SEAM(1); }
    if (EN(2) && IN(2)) {
        thin_phase(lds, bid, tid, lane, wave, G, P.in(0), P.in(1), nullptr, (_Float16*)(ws + WS_X16), nullptr, D, H, nullptr, MOD, 0, 0.f, false, P.in(9), MOD, 1, 0, true);
        SEAM(2);
    }
    const Ptrs P0 = P;
#pragma unroll 1
    for (int l = 0; l < 2; ++l) {
        const int base = 3 + 12 * l;
#pragma unroll 1
        for (int f = 0; f < 2; ++f) {
            const int bid = opaque_bid();
#define MK_IDS const int tid = opaque_tid(), lane = tid & 63, wave = __builtin_amdgcn_readfirstlane(tid >> 6), gw = bid * NWAVES + wave, gtid = bid * (NWAVES * 64) + tid; (void)gw; (void)gtid; (void)lane; (void)wave
            unsigned long long ws_i = (unsigned long long)args.ws, x_i = (unsigned long long)args.out; asm volatile("" : "+s"(ws_i), "+s"(x_i));
            unsigned char* ws = (unsigned char*)(GAS unsigned char*)ws_i; float* X = (float*)(GAS float*)x_i;
            bf16* H = (bf16*)(ws + WS_H); bf16* D = (bf16*)(ws + WS_R2); _Float16* X16 = (_Float16*)(ws + WS_X16);
            const float* MODL = (const float*)(ws + WS_MOD) + (size_t)l * 9 * NMODC;
            Ptrs P; P.tab = P0.tab; P.out = X; P.ws = ws;
            if (EN(3) && IN(base + 9 * f)) {
                pg8::Gemm g{(const pg8::bf16_t*)H, (const pg8::bf16_t*)(ws + WS_W1T) + (size_t)f * NFF2 * DM, M, NFF2, DM}; pg8::StaticOrder S; S.init(M, NFF2, G, bid);
                pg8::EpiSwiGLU E{(pg8::bf16_t*)(ws + WS_R1), DFF};
                _Pragma("unroll 1") for (int rep = 0; rep < REPS(3); ++rep) { pg8::gemm_phase<pg8::EpiSwiGLU, pg8::StaticOrder, true, true>(lds, g, S, E); }
                SEAM(base + 9 * f);
            }
            if (EN(4) && IN(base + 9 * f + 1)) {
                pg8::Gemm g{(const pg8::bf16_t*)(ws + WS_R1), (const pg8::bf16_t*)(ws + WS_W2T) + (size_t)f * DM * DFF, M, DM, DFF}; pg8::StaticOrder S; S.init(M, DM, G, bid);
                pg8::EpiBf16P E{(pg8::bf16_t*)D, DM};
                _Pragma("unroll 1") for (int rep = 0; rep < REPS(4); ++rep) { pg8::gemm_phase<pg8::EpiBf16P, pg8::StaticOrder, true, true>(lds, g, S, E); }
                SEAM(base + 9 * f + 1);
            }
            if (EN(5) && IN(base + 9 * f + 2)) {
                MK_IDS;
                if (f == 0) {
                    thin_phase(lds, bid, tid, lane, wave, G, nullptr, nullptr, X16, X16, nullptr, D, H, P.in(10) + (size_t)(l * 3 + 0) * DM, MODL, 2, 0.5f, true,
                               P.in(9) + (size_t)(l * 3 + 1) * DM, MODL, 4, 3, true);
                    if (REPS(5) == 2) thin_phase(lds, bid, tid, lane, wave, G, nullptr, nullptr, X16, X16, nullptr, D, H, P.in(10), MODL, 2, 0.5f, false, P.in(9) + (size_t)(l * 3 + 1) * DM, MODL, 4, 3, true);
                    _Pragma("unroll 1") for (int rep = 0; rep < REPS(13); ++rep) convert_cache(P, l, gtid, NTH);
                } else {
                    const bool more = (l == 0);
                    thin_phase(lds, bid, tid, lane, wave, G, nullptr, nullptr, X16, X16, more ? nullptr : X, D, H, P.in(10) + (size_t)(l * 3 + 2) * DM, MODL, 8, 0.5f, true,
                               P.in(9) + (size_t)((l + 1) * 3 + 0) * DM, MODL + 9 * NMODC, 1, 0, more);
                    if (more) { _Pragma("unroll 1") for (int rep = 0; rep < REPS(14); ++rep) convert_weights(P, l + 1, lds, gw, NGW, CW_NIT, wave, lane); }
                }
                SEAM(base + 9 * f + 2);
            }
            if (f == 1) break;
            if (EN(6) && IN(base + 3)) {
                pg8::Gemm g{(const pg8::bf16_t*)H, (const pg8::bf16_t*)(ws + WS_WINT), M, NIN, DM}; pg8::StaticOrder S; S.init(M, NIN, G, bid);
                float* ock = X + (size_t)M * DM + (size_t)l * 256 * 1024; float* ocv = ock + (size_t)MC * 1024 * 2;
                pg8::EpiWin E{(pg8::bf16_t*)(ws + WS_R1), (pg8::bf16_t*)(ws + WS_R1 + 96 * MiB), (pg8::bf16_t*)(ws + WS_R1 + 192 * MiB), (pg8::bf16_t*)(ws + WS_KB), (pg8::bf16_t*)(ws + WS_VB),
                              (pg8::bf16_t*)(ws + WS_GM), ock, ocv, (const float*)(ws + WS_ROPE), (const float*)(ws + WS_ROPE) + 1024};
                _Pragma("unroll 1") for (int rep = 0; rep < REPS(6); ++rep) { pg8::gemm_phase<pg8::EpiWin, pg8::StaticOrder, true, true>(lds, g, S, E); }
                SEAM(base + 3);
            }
            if (IN(base + 4)) {
                MK_IDS;
                if (EN(7)) { _Pragma("unroll 1") for (int rep = 0; rep < REPS(7); ++rep) lru_phase<1>(P, l, lds, bid, tid, lane, wave, G); }
                if (EN(8)) { _Pragma("unroll 1") for (int rep = 0; rep < REPS(8); ++rep) attn_phase<0>(P, l, (char*)lds_raw, bid, lane, G); }
                SEAM(base + 4);
            }
            if (IN(base + 5)) {
                MK_IDS;
                if (EN(7)) { _Pragma("unroll 1") for (int rep = 0; rep < REPS(9); ++rep) lru_phase<2>(P, l, lds, bid, tid, lane, wave, G); }
                if (EN(8)) { _Pragma("unroll 1") for (int rep = 0; rep < REPS(8); ++rep) attn_phase<1>(P, l, (char*)lds_raw, bid, lane, G); }
                SEAM(base + 5);
            }
            if (EN(10) && IN(base + 6)) {
                _Pragma("unroll 1") for (int rep = 0; rep < REPS(10); ++rep) {
                { pg8::Gemm g{(const pg8::bf16_t*)(ws + WS_HF), (const pg8::bf16_t*)(ws + WS_PLRUT), M, DM, DM}; pg8::StaticOrder S; S.init(M, DM, G, bid);
                  pg8::EpiGate1 E{(_Float16*)(ws + WS_HB), (const pg8::bf16_t*)(ws + WS_GM)};
                  pg8::gemm_phase<pg8::EpiGate1, pg8::StaticOrder, true, true>(lds, g, S, E); }
                { pg8::Gemm g{(const pg8::bf16_t*)(ws + WS_R2), (const pg8::bf16_t*)(ws + WS_PATTNT), M, DM, 1024}; pg8::StaticOrder S; S.init(M, DM, G, bid);
                  pg8::EpiGate2 E{(const _Float16*)(ws + WS_HB), (const pg8::bf16_t*)(ws + WS_GM), (pg8::bf16_t*)H};
                  pg8::gemm_phase<pg8::EpiGate2, pg8::StaticOrder, true, true>(lds, g, S, E); } }
                SEAM(base + 6);
            }
            if (EN(11) && IN(base + 7)) {
                pg8::Gemm g{(const pg8::bf16_t*)H, (const pg8::bf16_t*)(ws + WS_WOUTT), M, DM, DM}; pg8::StaticOrder S; S.init(M, DM, G, bid);
                pg8::EpiBf16P E{(pg8::bf16_t*)D, DM};
                _Pragma("unroll 1") for (int rep = 0; rep < REPS(11); ++rep) { pg8::gemm_phase<pg8::EpiBf16P, pg8::StaticOrder, true, true>(lds, g, S, E); }
                SEAM(base + 7);
            }
            if (EN(12) && IN(base + 8)) {
                MK_IDS;
                thin_phase(lds, bid, tid, lane, wave, G, nullptr, nullptr, X16, X16, nullptr, D, H, P.in(10) + (size_t)(l * 3 + 1) * DM, MODL, 5, 1.0f, true,
                           P.in(9) + (size_t)(l * 3 + 2) * DM, MODL, 7, 6, true);
                SEAM(base + 8);
            }
        }
    }
#undef MK_IDS
#undef IN
#undef SEAM
}

#ifndef MK_SPLIT
#define MK_SPLIT 0
#endif
extern "C" void kernel_launch(void* const* d_in, const int* in_sizes, int n_in, void* d_out, int out_size, void* d_ws, size_t ws_size, hipStream_t stream) {
    static int grid = 0;
    if (grid == 0) {
        if (n_in != 29 || ws_size < WS_END) { fprintf(stderr, "kernel_launch: need 29 inputs and >= %zu bytes of workspace; got %d, %zu\n", (size_t)WS_END, n_in, ws_size); grid = -1; return; }
        int dev = 0, cus = 0, per_cu = 0;
        if (hipGetDevice(&dev) != hipSuccess || hipDeviceGetAttribute(&cus, hipDeviceAttributeMultiprocessorCount, dev) != hipSuccess) { grid = -1; return; }
        if (hipFuncSetAttribute((const void*)mega_fwd, hipFuncAttributeMaxDynamicSharedMemorySize, LDS_BYTES) != hipSuccess) { fprintf(stderr, "kernel_launch: hipFuncSetAttribute failed\n"); grid = -1; return; }
        if (hipOccupancyMaxActiveBlocksPerMultiprocessor(&per_cu, (const void*)mega_fwd, NWAVES * 64, LDS_BYTES) != hipSuccess || per_cu < 1) { fprintf(stderr, "kernel_launch: occupancy query says %d\n", per_cu); (void)hipGetLastError(); grid = -1; return; }
        grid = cus;
    }
    if (grid < 0) return;
    (void)hipMemsetAsync((char*)d_ws + WS_CTL, 0, CTL_ZERO_BYTES, stream);
    Args a{};
    for (int i = 0; i < 29; ++i) a.in[i] = (const float*)d_in[i];
    a.out = (float*)d_out; a.ws = (unsigned char*)d_ws;
#if MK_SPLIT
    for (int p = 0; p < NPHASE; ++p) { a.ph_lo = p; a.ph_hi = p + 1; hipLaunchKernelGGL(mega_fwd, dim3(grid), dim3(NWAVES * 64), LDS_BYTES, stream, a); }
#else
    a.ph_lo = 0; a.ph_hi = NPHASE;
    hipLaunchKernelGGL(mega_fwd, dim3(grid), dim3(NWAVES * 64), LDS_BYTES, stream, a);
#endif
    const hipError_t le = hipPeekAtLastError();
    if (le != hipSuccess) fprintf(stderr, "kernel_launch: launch failed: %s\n", hipGetErrorName(le));
}
```

```cpp
#include <hip/hip_runtime.h>
#include <cstdio>
#include <cstdint>
__device__ __forceinline__ int opaque_tid() { int t = (int)threadIdx.x; asm volatile("" : "+v"(t)); return t; }
__device__ __forceinline__ int opaque_bid() { int b = (int)blockIdx.x; asm volatile("" : "+s"(b)); return b; }
namespace pg8 {
#define PG8_LAS __attribute__((address_space(3)))
typedef unsigned short bf16_t;
typedef short bf16x8 __attribute__((ext_vector_type(8)));
typedef float f32x4 __attribute__((ext_vector_type(4)));
typedef unsigned u32x4 __attribute__((ext_vector_type(4)));
constexpr int BM = 256, BK = 64, HALF = 128, HTB = HALF * BK * 2  , STAGE_BYTES = 8 * HTB, NXCD = 8, WGM = 8;

__host__ __device__ __forceinline__ int lds_byte(int r, int c) { const int st = (r >> 4) * 2 + (c >> 5), rr = r & 15, cc = c & 31, ob = rr * 64 + cc * 2; return st * 1024 + (ob ^ (((ob >> 9) & 1) << 5)); }
__host__ __device__ __forceinline__ void stage_rc(int b, int& R, int& C) { const int st = b / 1024, sb = b % 1024, swz = sb ^ (((sb >> 9) & 1) << 5); R = (st >> 1) * 16 + swz / 64; C = (st & 1) * 32 + (swz % 64) / 2; }
__host__ __device__ __forceinline__ int perm32(int rho) { const int n = rho >> 4, i = rho & 15; return 8 * (i >> 2) + 4 * n + (i & 3); }

struct Unit { int pm, pn; };
struct Gemm { const bf16_t* A; const bf16_t* Bt; int M, N, K; };

struct StaticOrder {
    int nM, nN, nwg, G, c;
    __host__ __device__ void init(int M, int N, int G_, int c_) { nM = M / BM; nN = N / BM; nwg = nM * nN; G = G_; c = c_; }
    __host__ __device__ bool next(int i, Unit& u) const {
        const long L = (long)i * G + c; if (L >= nwg) return false;
        int wgid = (int)L; { const int q = nwg / NXCD, r = nwg % NXCD, xcd = wgid % NXCD, off = wgid / NXCD; wgid = (xcd < r ? xcd * (q + 1) : r * (q + 1) + (xcd - r) * q) + off; }
        const int nig = WGM * nN, gid = wgid / nig, fm = gid * WGM, gsz = (nM - fm) < WGM ? (nM - fm) : WGM;
        u.pm = fm + ((wgid % nig) % gsz); u.pn = (wgid % nig) / gsz; return true;
    }
    __device__ __forceinline__ void a_ready(const Unit&) const {}
    __device__ __forceinline__ void done(const Unit&) const {}
};
typedef __bf16 cvt_bf2 __attribute__((ext_vector_type(2)));
typedef float cvt_f2 __attribute__((ext_vector_type(2)));
__device__ __forceinline__ unsigned cvt_pk_bf16(float lo, float hi) { const cvt_f2 v = {lo, hi}; const cvt_bf2 r = __builtin_convertvector(v, cvt_bf2); return __builtin_bit_cast(unsigned, r); }
typedef unsigned u32x2 __attribute__((ext_vector_type(2)));
__device__ __forceinline__ float sigm(float x) { return __builtin_amdgcn_rcpf(1.0f + __builtin_amdgcn_exp2f(-1.4426950408889634f * x)); }
__device__ __forceinline__ float gelu_tanh(float x) { return x * sigm(1.5957691216057308f * x * (1.0f + 0.044715f * x * x)); }
__device__ __forceinline__ void st4bf(bf16_t* p, f32x4 v) { u32x2 w; w.x = cvt_pk_bf16(v[0], v[1]); w.y = cvt_pk_bf16(v[2], v[3]); *(u32x2*)p = w; }
__device__ __forceinline__ f32x4 ld4bf(const bf16_t* p) { const u32x2 w = *(const u32x2*)p; f32x4 v; v[0] = __uint_as_float(w.x << 16); v[1] = __uint_as_float(w.x & 0xffff0000u); v[2] = __uint_as_float(w.y << 16); v[3] = __uint_as_float(w.y & 0xffff0000u); return v; }

struct EpiSwiGLU {
    static constexpr bool PERM = true, AFTER_DRAIN = false; static constexpr int NVM = 8;
    bf16_t* O; int ldc;
    __device__ __forceinline__ void operator()(const f32x4 (&acc)[2][2][4][2], const Unit& u, int wr, int wc, int fr, int fq) const {
        const int row0 = u.pm * BM + wr * 64 + fr, col0 = u.pn * HALF + wc * 32 + 8 * fq;
#pragma unroll
        for (int ai = 0; ai < 2; ++ai)
#pragma unroll
            for (int m = 0; m < 4; ++m) {
                bf16_t* p = O + (size_t)(row0 + ai * HALF + m * 16) * ldc + col0;
                const f32x4 g0 = acc[ai][0][m][0], g1 = acc[ai][0][m][1], u0 = acc[ai][1][m][0], u1 = acc[ai][1][m][1];
                float v[8];
#pragma unroll
                for (int i = 0; i < 4; ++i) { v[i] = g0[i] * sigm(g0[i]) * u0[i]; v[4 + i] = g1[i] * sigm(g1[i]) * u1[i]; }
                u32x4 w; w.x = cvt_pk_bf16(v[0], v[1]); w.y = cvt_pk_bf16(v[2], v[3]); w.z = cvt_pk_bf16(v[4], v[5]); w.w = cvt_pk_bf16(v[6], v[7]);
                *(u32x4*)p = w;
            }
    }
};
struct EpiF32 {
    static constexpr bool PERM = false, AFTER_DRAIN = false;
    float* C; int ldc;
    __device__ __forceinline__ void operator()(const f32x4 (&acc)[2][2][4][2], const Unit& u, int wr, int wc, int fr, int fq) const {
        const int row0 = u.pm * BM + wr * 64 + fr, col0 = u.pn * BM + wc * 32 + 4 * fq;
#pragma unroll
        for (int ai = 0; ai < 2; ++ai)
#pragma unroll
            for (int m = 0; m < 4; ++m) { float* rowp = C + (size_t)(row0 + ai * HALF + m * 16) * ldc + col0;
#pragma unroll
                for (int bj = 0; bj < 2; ++bj)
#pragma unroll
                    for (int n = 0; n < 2; ++n) *(f32x4*)(rowp + bj * HALF + n * 16) = acc[ai][bj][m][n]; }
    }
};
struct EpiBf16P {
    static constexpr bool PERM = true, AFTER_DRAIN = false; static constexpr int NVM = 16;
    bf16_t* O; int ldc;
    __device__ __forceinline__ void operator()(const f32x4 (&acc)[2][2][4][2], const Unit& u, int wr, int wc, int fr, int fq) const {
        const int row0 = u.pm * BM + wr * 64 + fr, col0 = u.pn * BM + wc * 32 + 8 * fq;
#pragma unroll
        for (int ai = 0; ai < 2; ++ai)
#pragma unroll
            for (int m = 0; m < 4; ++m) { bf16_t* rowp = O + (size_t)(row0 + ai * HALF + m * 16) * ldc + col0;
#pragma unroll
                for (int bj = 0; bj < 2; ++bj) { const f32x4 v0 = acc[ai][bj][m][0], v1 = acc[ai][bj][m][1];
                    u32x4 w; w.x = cvt_pk_bf16(v0[0], v0[1]); w.y = cvt_pk_bf16(v0[2], v0[3]); w.z = cvt_pk_bf16(v1[0], v1[1]); w.w = cvt_pk_bf16(v1[2], v1[3]);
                    *(u32x4*)(rowp + bj * HALF) = w; } }
    }
};
struct EpiWin {
    static constexpr bool PERM = true, AFTER_DRAIN = false; static constexpr int NVM = 16;
    bf16_t *XR, *GR, *Q, *KB, *VB, *GM; float *ock, *ocv; const float *rc, *rs;
    __device__ __forceinline__ void operator()(const f32x4 (&acc)[2][2][4][2], const Unit& u, int wr, int wc, int fr, int fq) const {
        const int pn = u.pn, rl0 = wr * 64 + fr, c0 = wc * 32 + 4 * fq, c8 = wc * 32 + 8 * fq;
        const bool samp = u.pm >= 32;
        if (pn < 16 || pn >= 28) {
            bf16_t* base; int ld; int mode;
            if (pn < 8) { base = XR + pn * BM; ld = 2048; mode = 0; }
            else if (pn < 16) { base = GR + (pn - 8) * BM; ld = 2048; mode = 1; }
            else { base = GM + (pn - 28) * BM; ld = 4096; mode = 2; }
            base += (size_t)(u.pm * BM + rl0) * ld + c8;
#define EPIWIN_ROWS(F) _Pragma("unroll") for (int ai = 0; ai < 2; ++ai) _Pragma("unroll") for (int m = 0; m < 4; ++m) { bf16_t* rowp = base + (size_t)(ai * HALF + m * 16) * ld; \
                _Pragma("unroll") for (int bj = 0; bj < 2; ++bj) { const f32x4 v0 = acc[ai][bj][m][0], v1 = acc[ai][bj][m][1]; u32x4 w; \
                    w.x = cvt_pk_bf16(F(v0[0]), F(v0[1])); w.y = cvt_pk_bf16(F(v0[2]), F(v0[3])); w.z = cvt_pk_bf16(F(v1[0]), F(v1[1])); w.w = cvt_pk_bf16(F(v1[2]), F(v1[3])); \
                    *(u32x4*)(rowp + bj * HALF) = w; } }
#define EPIWIN_ID(x) (x)
            if (mode == 0) { EPIWIN_ROWS(EPIWIN_ID) }
            else if (mode == 1) { EPIWIN_ROWS(gelu_tanh) }
            else { EPIWIN_ROWS(sigm) }
#undef EPIWIN_ID
#undef EPIWIN_ROWS
            return;
        }
        int b, t0, kvrow0;
        if (samp) { const int ms0 = (u.pm - 32) * BM; b = ms0 >> 11; t0 = ms0 & 2047; kvrow0 = 8192 + b * 2560 + 512 + t0; }
        else { b = u.pm; t0 = 0; kvrow0 = u.pm * BM; }
        if (pn < 24) {
            const bool isk = pn >= 20; const int cb = (isk ? pn - 20 : pn - 16) * BM + c0;
            bf16_t* dst = isk ? KB + (size_t)(kvrow0 + rl0) * 1024 + cb : Q + (size_t)(u.pm * BM + rl0) * 1024 + cb;
            if (samp) {
                const int axis = wc & 1;
#pragma unroll
                for (int ai = 0; ai < 2; ++ai)
#pragma unroll
                    for (int m = 0; m < 4; ++m) { const int t = t0 + rl0 + ai * HALF + m * 16; const int pos = axis ? (t & 63) : (t >> 6);
                        const f32x4 c4 = *(const f32x4*)(rc + pos * 16 + 4 * fq), s4 = *(const f32x4*)(rs + pos * 16 + 4 * fq);
                        bf16_t* rowp = dst + (size_t)(ai * HALF + m * 16) * 1024;
#pragma unroll
                        for (int bj = 0; bj < 2; ++bj) { const f32x4 x1 = acc[ai][bj][m][0], x2 = acc[ai][bj][m][1];
                            st4bf(rowp + bj * HALF, x1 * c4 - x2 * s4); st4bf(rowp + bj * HALF + 16, x2 * c4 + x1 * s4); }
                        asm volatile("" ::: "memory"); }
            } else {
                float* oc = isk ? ock + ((size_t)b * 512 + rl0) * 1024 + cb : nullptr;
#pragma unroll
                for (int ai = 0; ai < 2; ++ai)
#pragma unroll
                    for (int m = 0; m < 4; ++m) { bf16_t* rowp = dst + (size_t)(ai * HALF + m * 16) * 1024;
#pragma unroll
                        for (int bj = 0; bj < 2; ++bj)
#pragma unroll
                            for (int n = 0; n < 2; ++n) { st4bf(rowp + bj * HALF + n * 16, acc[ai][bj][m][n]);
                                if (isk) *(f32x4*)(oc + (size_t)(ai * HALF + m * 16) * 1024 + bj * HALF + n * 16) = acc[ai][bj][m][n]; } }
            }
        } else {
            const int cb = (pn - 24) * BM + c8;
            bf16_t* dst = VB + (size_t)(kvrow0 + rl0) * 1024 + cb;
            float* oc = ocv + ((size_t)b * 512 + rl0) * 1024 + cb;
#pragma unroll
            for (int ai = 0; ai < 2; ++ai)
#pragma unroll
                for (int m = 0; m < 4; ++m) { bf16_t* rowp = dst + (size_t)(ai * HALF + m * 16) * 1024;
#pragma unroll
                    for (int bj = 0; bj < 2; ++bj) { const f32x4 v0 = acc[ai][bj][m][0], v1 = acc[ai][bj][m][1];
                        u32x4 w; w.x = cvt_pk_bf16(v0[0], v0[1]); w.y = cvt_pk_bf16(v0[2], v0[3]); w.z = cvt_pk_bf16(v1[0], v1[1]); w.w = cvt_pk_bf16(v1[2], v1[3]);
                        *(u32x4*)(rowp + bj * HALF) = w;
                        if (!samp) { float* op = oc + (size_t)(ai * HALF + m * 16) * 1024 + bj * HALF; *(f32x4*)op = v0; *(f32x4*)(op + 4) = v1; } } }
        }
    }
};
typedef _Float16 h16x4e __attribute__((ext_vector_type(4)));
typedef _Float16 h16x8e __attribute__((ext_vector_type(8)));
struct EpiGate1 {
    static constexpr bool PERM = true, AFTER_DRAIN = false; static constexpr int NVM = 32;
    _Float16* U16; const bf16_t* GM;
    __device__ __forceinline__ void operator()(const f32x4 (&acc)[2][2][4][2], const Unit& u, int wr, int wc, int fr, int fq) const {
        const int row0 = u.pm * BM + wr * 64 + fr, col0 = u.pn * BM + wc * 32 + 8 * fq;
        u32x4 g[2][4][2];
#pragma unroll
        for (int ai = 0; ai < 2; ++ai)
#pragma unroll
            for (int m = 0; m < 4; ++m)
#pragma unroll
                for (int bj = 0; bj < 2; ++bj) g[ai][m][bj] = *(const u32x4*)(GM + (size_t)(row0 + ai * HALF + m * 16) * 4096 + col0 + bj * HALF);
#pragma unroll
        for (int ai = 0; ai < 2; ++ai)
#pragma unroll
            for (int m = 0; m < 4; ++m)
#pragma unroll
                for (int bj = 0; bj < 2; ++bj) { const u32x4 q = g[ai][m][bj]; const f32x4 v0 = acc[ai][bj][m][0], v1 = acc[ai][bj][m][1];
                    h16x8e hv;
                    hv[0] = (_Float16)(__uint_as_float(q.x << 16) * v0[0]); hv[1] = (_Float16)(__uint_as_float(q.x & 0xffff0000u) * v0[1]);
                    hv[2] = (_Float16)(__uint_as_float(q.y << 16) * v0[2]); hv[3] = (_Float16)(__uint_as_float(q.y & 0xffff0000u) * v0[3]);
                    hv[4] = (_Float16)(__uint_as_float(q.z << 16) * v1[0]); hv[5] = (_Float16)(__uint_as_float(q.z & 0xffff0000u) * v1[1]);
                    hv[6] = (_Float16)(__uint_as_float(q.w << 16) * v1[2]); hv[7] = (_Float16)(__uint_as_float(q.w & 0xffff0000u) * v1[3]);
                    *(h16x8e*)(U16 + (size_t)(row0 + ai * HALF + m * 16) * 2048 + col0 + bj * HALF) = hv; }
    }
};
struct EpiGate2 {
    static constexpr bool PERM = true, AFTER_DRAIN = false; static constexpr int NVM = 48;
    const _Float16* U16; const bf16_t* GM; bf16_t* U;
    __device__ __forceinline__ void operator()(const f32x4 (&acc)[2][2][4][2], const Unit& u, int wr, int wc, int fr, int fq) const {
        const int row0 = u.pm * BM + wr * 64 + fr, col0 = u.pn * BM + wc * 32 + 8 * fq;
#pragma unroll
        for (int ai = 0; ai < 2; ++ai) {
            u32x4 g[4][2]; h16x8e h[4][2];
#pragma unroll
            for (int m = 0; m < 4; ++m)
#pragma unroll
                for (int bj = 0; bj < 2; ++bj) { const size_t r = (size_t)(row0 + ai * HALF + m * 16);
                    g[m][bj] = *(const u32x4*)(GM + r * 4096 + 2048 + col0 + bj * HALF); h[m][bj] = *(const h16x8e*)(U16 + r * 2048 + col0 + bj * HALF); }
#pragma unroll
            for (int m = 0; m < 4; ++m)
#pragma unroll
                for (int bj = 0; bj < 2; ++bj) { const u32x4 q = g[m][bj]; const h16x8e hv = h[m][bj]; const f32x4 v0 = acc[ai][bj][m][0], v1 = acc[ai][bj][m][1];
                    u32x4 w;
                    w.x = cvt_pk_bf16((float)hv[0] + __uint_as_float(q.x << 16) * v0[0], (float)hv[1] + __uint_as_float(q.x & 0xffff0000u) * v0[1]);
                    w.y = cvt_pk_bf16((float)hv[2] + __uint_as_float(q.y << 16) * v0[2], (float)hv[3] + __uint_as_float(q.y & 0xffff0000u) * v0[3]);
                    w.z = cvt_pk_bf16((float)hv[4] + __uint_as_float(q.z << 16) * v1[0], (float)hv[5] + __uint_as_float(q.z & 0xffff0000u) * v1[1]);
                    w.w = cvt_pk_bf16((float)hv[6] + __uint_as_float(q.w << 16) * v1[2], (float)hv[7] + __uint_as_float(q.w & 0xffff0000u) * v1[3]);
                    *(u32x4*)(U + (size_t)(row0 + ai * HALF + m * 16) * 2048 + col0 + bj * HALF) = w; }
            asm volatile("" ::: "memory");
        }
    }
};
struct EpiGateM {
    static constexpr bool PERM = true, AFTER_DRAIN = false; static constexpr int NVM = 16;
    const bf16_t* GM; bf16_t* U;
    __device__ __forceinline__ void mid(f32x4 (&acc)[2][2][4][2], const Unit& u, int wr, int wc, int fr, int fq) const {
        const int row0 = u.pm * BM + wr * 64 + fr, col0 = u.pn * BM + wc * 32 + 8 * fq;
#pragma unroll
        for (int ai = 0; ai < 2; ++ai) {
            u32x4 g1[4][2], g2[4][2];
#pragma unroll
            for (int m = 0; m < 4; ++m)
#pragma unroll
                for (int bj = 0; bj < 2; ++bj) { const bf16_t* gp = GM + (size_t)(row0 + ai * HALF + m * 16) * 4096 + col0 + bj * HALF;
                    g1[m][bj] = *(const u32x4*)gp; g2[m][bj] = *(const u32x4*)(gp + 2048); }
#pragma unroll
            for (int m = 0; m < 4; ++m)
#pragma unroll
                for (int bj = 0; bj < 2; ++bj) { const u32x4 a = g1[m][bj], b = g2[m][bj];
                    const unsigned aw[4] = {a.x, a.y, a.z, a.w}, bw[4] = {b.x, b.y, b.z, b.w};
#pragma unroll
                    for (int q = 0; q < 4; ++q) {
                        const float n0 = __uint_as_float(aw[q] << 16), n1 = __uint_as_float(aw[q] & 0xffff0000u), d0 = __uint_as_float(bw[q] << 16), d1 = __uint_as_float(bw[q] & 0xffff0000u);
                        const float r0 = n0 * __builtin_amdgcn_rcpf(fmaxf(d0, 1e-30f)), r1 = n1 * __builtin_amdgcn_rcpf(fmaxf(d1, 1e-30f));
                        acc[ai][bj][m][q >> 1][(q & 1) * 2] *= r0; acc[ai][bj][m][q >> 1][(q & 1) * 2 + 1] *= r1; } }
            asm volatile("" ::: "memory");
        }
    }
    __device__ __forceinline__ void operator()(const f32x4 (&acc)[2][2][4][2], const Unit& u, int wr, int wc, int fr, int fq) const {
        const int row0 = u.pm * BM + wr * 64 + fr, col0 = u.pn * BM + wc * 32 + 8 * fq;
        u32x4 g[2][4][2];
#pragma unroll
        for (int ai = 0; ai < 2; ++ai)
#pragma unroll
            for (int m = 0; m < 4; ++m)
#pragma unroll
                for (int bj = 0; bj < 2; ++bj) g[ai][m][bj] = *(const u32x4*)(GM + (size_t)(row0 + ai * HALF + m * 16) * 4096 + 2048 + col0 + bj * HALF);
#pragma unroll
        for (int ai = 0; ai < 2; ++ai)
#pragma unroll
            for (int m = 0; m < 4; ++m)
#pragma unroll
                for (int bj = 0; bj < 2; ++bj) { const u32x4 q = g[ai][m][bj]; const f32x4 v0 = acc[ai][bj][m][0], v1 = acc[ai][bj][m][1];
                    u32x4 w;
                    w.x = cvt_pk_bf16(__uint_as_float(q.x << 16) * v0[0], __uint_as_float(q.x & 0xffff0000u) * v0[1]);
                    w.y = cvt_pk_bf16(__uint_as_float(q.y << 16) * v0[2], __uint_as_float(q.y & 0xffff0000u) * v0[3]);
                    w.z = cvt_pk_bf16(__uint_as_float(q.z << 16) * v1[0], __uint_as_float(q.z & 0xffff0000u) * v1[1]);
                    w.w = cvt_pk_bf16(__uint_as_float(q.w << 16) * v1[2], __uint_as_float(q.w & 0xffff0000u) * v1[3]);
                    *(u32x4*)(U + (size_t)(row0 + ai * HALF + m * 16) * 2048 + col0 + bj * HALF) = w; }
    }
};
template <class Epi, class Sched, bool ALIGN_EPI = false, bool SP2 = false>
__device__ __forceinline__ void gemm_phase(PG8_LAS unsigned char* lds, const Gemm g, const Sched& S, const Epi& E) {
    const int tid = opaque_tid(), wid = __builtin_amdgcn_readfirstlane(tid >> 6), lane = tid & 63, wr = wid >> 2, wc = wid & 3, fr = lane & 15, fq = lane >> 4;
    const int K = g.K, nt = K / BK;
    unsigned voffA[2], voffB[2];
#pragma unroll
    for (int i = 0; i < 2; ++i) { int R, C; stage_rc(tid * 16 + i * 8192, R, C); const int Rb = Epi::PERM ? ((R & ~31) + perm32(R & 31)) : R;
        voffA[i] = (unsigned)(R * K + C) * 2u; voffB[i] = (unsigned)(Rb * K + C) * 2u; }
    const size_t kstep = (size_t)(BK * 2);
    const size_t hstep = (size_t)HALF * K * 2;
    const size_t tstep = 2 * hstep;
    const unsigned ldsw = (unsigned)wid * 1024u;
    const int aoff = lds_byte(wr * 64 + fr, fq * 8), boff = lds_byte(wc * 32 + fr, fq * 8);
#define PG8_SA(b, h) (((b) * 2 + (h)) * HTB)
#define PG8_SB(b, h) ((4 + (b) * 2 + (h)) * HTB)
#define PG8_STAGE(bufoff, gbase, voff) do { _Pragma("unroll") for (int _i = 0; _i < 2; ++_i) \
        __builtin_amdgcn_global_load_lds((const unsigned*)((const char*)(gbase) + (voff)[_i]), (PG8_LAS unsigned*)(lds + (bufoff) + ldsw + _i * 8192), 16, 0, 0); } while (0)
#define PG8_LDA(dst, b, h) do { _Pragma("unroll") for (int m = 0; m < 4; ++m) _Pragma("unroll") for (int k = 0; k < 2; ++k) dst[m][k] = *(const PG8_LAS bf16x8*)(lds + PG8_SA(b, h) + aoff + m * 2048 + k * 1024); } while (0)
#define PG8_LDB(dst, b, h) do { _Pragma("unroll") for (int n = 0; n < 2; ++n) _Pragma("unroll") for (int k = 0; k < 2; ++k) dst[n][k] = *(const PG8_LAS bf16x8*)(lds + PG8_SB(b, h) + boff + n * 2048 + k * 1024); } while (0)
#define PG8_MMA(ai, bj, At, Bt) do { __builtin_amdgcn_s_setprio(1); _Pragma("unroll") for (int m = 0; m < 4; ++m) _Pragma("unroll") for (int n = 0; n < 2; ++n) _Pragma("unroll") for (int k = 0; k < 2; ++k) \
        acc[ai][bj][m][n] = __builtin_amdgcn_mfma_f32_16x16x32_bf16(Bt[n][k], At[m][k], acc[ai][bj][m][n], 0, 0, 0); __builtin_amdgcn_s_setprio(0); } while (0)
#define PG8_WAIT_V(n) asm volatile("s_waitcnt vmcnt(" #n ")" ::: "memory")
#define PG8_WAIT_L(n) asm volatile("s_waitcnt lgkmcnt(" #n ")" ::: "memory")
#define PG8_WAIT_VR asm volatile("s_waitcnt vmcnt(%0)" :: "n"(8 + Epi::NVM) : "memory")
#define PG8_BAR __builtin_amdgcn_s_barrier()
#define PG8_SCHED __builtin_amdgcn_sched_barrier(0)
    Unit cur, nxt; int ui = 0;
    if (!S.next(0, cur)) return;
    f32x4 acc[2][2][4][2];
#pragma unroll
    for (int a = 0; a < 2; ++a)
#pragma unroll
        for (int b = 0; b < 2; ++b)
#pragma unroll
            for (int m = 0; m < 4; ++m)
#pragma unroll
                for (int n = 0; n < 2; ++n) acc[a][b][m][n] = (f32x4){0.f, 0.f, 0.f, 0.f};
    bf16x8 At[4][2], B0[2][2], B1[2][2];
    const char* cA = (const char*)g.A + (size_t)cur.pm * tstep; const char* cB = (const char*)g.Bt + (size_t)cur.pn * tstep;
    S.a_ready(cur);
    if constexpr (SP2) {
        PG8_STAGE(PG8_SB(0, 0), cB, voffB); PG8_STAGE(PG8_SB(0, 1), cB + hstep, voffB); PG8_STAGE(PG8_SA(0, 0), cA, voffA); PG8_STAGE(PG8_SA(0, 1), cA + hstep, voffA);
        if (wr == 1) PG8_BAR;
        PG8_WAIT_V(2); PG8_BAR;
        PG8_STAGE(PG8_SB(1, 0), cB + kstep, voffB); PG8_STAGE(PG8_SA(1, 0), cA + kstep, voffA); PG8_STAGE(PG8_SB(1, 1), cB + hstep + kstep, voffB);
        PG8_WAIT_V(6); PG8_BAR;
    } else {
        PG8_STAGE(PG8_SB(0, 0), cB, voffB); PG8_STAGE(PG8_SA(0, 0), cA, voffA); PG8_STAGE(PG8_SB(0, 1), cB + hstep, voffB); PG8_STAGE(PG8_SA(0, 1), cA + hstep, voffA);
        if (wr == 1) PG8_BAR;
        PG8_WAIT_V(4); PG8_BAR;
        PG8_STAGE(PG8_SB(1, 0), cB + kstep, voffB); PG8_STAGE(PG8_SA(1, 0), cA + kstep, voffA); PG8_STAGE(PG8_SB(1, 1), cB + hstep + kstep, voffB);
        PG8_WAIT_V(6); PG8_BAR;
    }
    bool relax = false;
    for (;;) {
        const bool has_next = S.next(ui + 1, nxt);
        const char* nA = has_next ? (const char*)g.A + (size_t)nxt.pm * tstep : cA; const char* nB = has_next ? (const char*)g.Bt + (size_t)nxt.pn * tstep : cB;
#pragma unroll
        for (int a = 0; a < 2; ++a)
#pragma unroll
            for (int b = 0; b < 2; ++b)
#pragma unroll
                for (int m = 0; m < 4; ++m)
#pragma unroll
                    for (int n = 0; n < 2; ++n) asm volatile("" : "+v"(acc[a][b][m][n]));
        if constexpr (SP2) {
#define PG8_KITER(t, WVA, STG1) do { \
            const bool last = ((t) == nt - 2); \
            const char* a1 = cA + (size_t)((t) + 1) * kstep;                                           \
            const char* a2 = last ? nA : cA + (size_t)((t) + 2) * kstep; const char* b2 = last ? nB : cB + (size_t)((t) + 2) * kstep;     \
            const char* a3 = a2 + kstep; const char* b3 = b2 + kstep;                                \
            if (last && has_next) S.a_ready(nxt); \
              \
            PG8_LDB(B0, 0, 0); PG8_LDB(B1, 0, 1); PG8_SCHED; PG8_LDA(At, 0, 0); STG1; \
            WVA; PG8_WAIT_L(0); PG8_BAR; PG8_MMA(0, 0, At, B0); PG8_MMA(0, 1, At, B1); PG8_BAR; PG8_SCHED; \
              \
            PG8_LDA(At, 0, 1); PG8_STAGE(PG8_SB(0, 0), b2, voffB); PG8_STAGE(PG8_SB(0, 1), b2 + hstep, voffB); PG8_STAGE(PG8_SA(0, 0), a2, voffA); \
            WVA; PG8_WAIT_L(0); PG8_BAR; PG8_MMA(1, 0, At, B0); PG8_MMA(1, 1, At, B1); PG8_BAR; PG8_SCHED; \
              \
            PG8_LDB(B0, 1, 0); PG8_LDB(B1, 1, 1); PG8_SCHED; PG8_LDA(At, 1, 0); PG8_STAGE(PG8_SA(0, 1), a2 + hstep, voffA); \
            WVA; PG8_WAIT_L(0); PG8_BAR; PG8_MMA(0, 0, At, B0); PG8_MMA(0, 1, At, B1); PG8_BAR; PG8_SCHED; \
              \
            PG8_LDA(At, 1, 1); PG8_STAGE(PG8_SB(1, 0), b3, voffB); PG8_STAGE(PG8_SB(1, 1), b3 + hstep, voffB); PG8_STAGE(PG8_SA(1, 0), a3, voffA); \
            PG8_WAIT_V(8); PG8_WAIT_L(0); PG8_BAR; PG8_MMA(1, 0, At, B0); PG8_MMA(1, 1, At, B1); PG8_BAR; PG8_SCHED; } while (0)
            int t = 0;
            if (relax) { PG8_KITER(0, PG8_WAIT_VR, (void)0); t = 2; }
#pragma unroll 1
            for (; t < nt; t += 2) PG8_KITER(t, PG8_WAIT_V(8), PG8_STAGE(PG8_SA(1, 1), a1 + hstep, voffA));
#undef PG8_KITER
        } else {
        for (int t = 0; t < nt; t += 2) {
            const bool last = (t == nt - 2);
            const char* a1 = cA + (size_t)(t + 1) * kstep;
            const char* a2 = last ? nA : cA + (size_t)(t + 2) * kstep; const char* b2 = last ? nB : cB + (size_t)(t + 2) * kstep;
            const char* a3 = a2 + kstep; const char* b3 = b2 + kstep;
            if (last && has_next) S.a_ready(nxt);
            PG8_LDB(B0, 0, 0); PG8_SCHED; PG8_LDA(At, 0, 0); PG8_STAGE(PG8_SA(1, 1), a1 + hstep, voffA);
            PG8_WAIT_L(8); PG8_BAR; PG8_WAIT_L(0); PG8_MMA(0, 0, At, B0); PG8_BAR; PG8_SCHED;
            PG8_LDB(B1, 0, 1); PG8_STAGE(PG8_SB(0, 0), b2, voffB);
            PG8_BAR; PG8_WAIT_L(0); PG8_MMA(0, 1, At, B1); PG8_BAR;
            PG8_LDA(At, 0, 1); PG8_STAGE(PG8_SA(0, 0), a2, voffA);
            PG8_BAR; PG8_WAIT_L(0); PG8_MMA(1, 0, At, B0); PG8_BAR; PG8_SCHED;
            PG8_STAGE(PG8_SB(0, 1), b2 + hstep, voffB);
            PG8_WAIT_V(6); PG8_BAR; PG8_MMA(1, 1, At, B1); PG8_BAR;
            PG8_LDB(B0, 1, 0); PG8_SCHED; PG8_LDA(At, 1, 0); PG8_STAGE(PG8_SA(0, 1), a2 + hstep, voffA);
            PG8_WAIT_L(8); PG8_BAR; PG8_WAIT_L(0); PG8_MMA(0, 0, At, B0); PG8_BAR; PG8_SCHED;
            PG8_LDB(B1, 1, 1); PG8_STAGE(PG8_SB(1, 0), b3, voffB);
            PG8_BAR; PG8_WAIT_L(0); PG8_MMA(0, 1, At, B1); PG8_BAR;
            PG8_LDA(At, 1, 1); PG8_STAGE(PG8_SA(1, 0), a3, voffA);
            PG8_BAR; PG8_WAIT_L(0); PG8_MMA(1, 0, At, B0); PG8_BAR; PG8_SCHED;
            PG8_STAGE(PG8_SB(1, 1), b3 + hstep, voffB);
            PG8_WAIT_V(6); PG8_BAR; PG8_MMA(1, 1, At, B1); PG8_BAR;
        }
        }
        if constexpr (ALIGN_EPI) { if (wr == 0) PG8_BAR; }
        if constexpr (SP2 && !Epi::AFTER_DRAIN) { if (has_next) { PG8_STAGE(PG8_SA(1, 1), nA + kstep + hstep, voffA); relax = true; } }
        if constexpr (!Epi::AFTER_DRAIN) {
            const int tz = opaque_tid(), widz = __builtin_amdgcn_readfirstlane(tz >> 6), lanez = tz & 63, wrz = widz >> 2, wcz = widz & 3, frz = lanez & 15, fqz = lanez >> 4;
            E(acc, cur, wrz, wcz, frz, fqz);
#if defined(REP_EPI)
            if constexpr (Epi::PERM) { asm volatile("" ::: "memory"); E(acc, cur, wrz, wcz, frz, fqz); }
#endif
            S.done(cur); }
        if (!has_next) break;
#pragma unroll
        for (int a = 0; a < 2; ++a)
#pragma unroll
            for (int b = 0; b < 2; ++b)
#pragma unroll
                for (int m = 0; m < 4; ++m)
#pragma unroll
                    for (int n = 0; n < 2; ++n) acc[a][b][m][n] = (f32x4){0.f, 0.f, 0.f, 0.f};
        cur = nxt; cA = nA; cB = nB; ++ui;
        if constexpr (ALIGN_EPI) { if (wr == 1) PG8_BAR; }
    }
    PG8_WAIT_V(0);
    if constexpr (!ALIGN_EPI) { if (wr == 0) PG8_BAR; }
    PG8_BAR;
    if constexpr (Epi::AFTER_DRAIN) { E.fused(acc, cur, wr, wc, fr, fq, lds, wid, lane); S.done(cur); }
#undef PG8_SA
#undef PG8_SB
#undef PG8_STAGE
#undef PG8_LDA
#undef PG8_LDB
#undef PG8_MMA
#undef PG8_WAIT_V
#undef PG8_WAIT_L
#undef PG8_WAIT_VR
#undef PG8_BAR
#undef PG8_SCHED
}
}
namespace pg8 {
template <class Epi, class Sched>
__device__ __forceinline__ void gemm_phase_dual(PG8_LAS unsigned char* lds, const Gemm g, const Gemm g2, const int nt2, const Sched& S, const Epi& E) {
    constexpr bool ALIGN_EPI = true, SP2 = true;
    const int tid = opaque_tid(), wid = __builtin_amdgcn_readfirstlane(tid >> 6), lane = tid & 63, wr = wid >> 2, wc = wid & 3, fr = lane & 15, fq = lane >> 4;
    const int K = g.K, nt1 = K / BK; int nt = nt1;
    unsigned voffA[2], voffB[2];
#pragma unroll
    for (int i = 0; i < 2; ++i) { int R, C; stage_rc(tid * 16 + i * 8192, R, C); const int Rb = Epi::PERM ? ((R & ~31) + perm32(R & 31)) : R;
        voffA[i] = (unsigned)(R * K + C) * 2u; voffB[i] = (unsigned)(Rb * K + C) * 2u; }
    const size_t kstep = (size_t)(BK * 2);
    const size_t hstep = (size_t)HALF * K * 2;
    const size_t tstep = 2 * hstep;
    const unsigned ldsw = (unsigned)wid * 1024u;
    const int aoff = lds_byte(wr * 64 + fr, fq * 8), boff = lds_byte(wc * 32 + fr, fq * 8);
#define PG8_SA(b, h) (((b) * 2 + (h)) * HTB)
#define PG8_SB(b, h) ((4 + (b) * 2 + (h)) * HTB)
#define PG8_STAGE(bufoff, gbase, voff) do { _Pragma("unroll") for (int _i = 0; _i < 2; ++_i) \
        __builtin_amdgcn_global_load_lds((const unsigned*)((const char*)(gbase) + (voff)[_i]), (PG8_LAS unsigned*)(lds + (bufoff) + ldsw + _i * 8192), 16, 0, 0); } while (0)
#define PG8_LDA(dst, b, h) do { _Pragma("unroll") for (int m = 0; m < 4; ++m) _Pragma("unroll") for (int k = 0; k < 2; ++k) dst[m][k] = *(const PG8_LAS bf16x8*)(lds + PG8_SA(b, h) + aoff + m * 2048 + k * 1024); } while (0)
#define PG8_LDB(dst, b, h) do { _Pragma("unroll") for (int n = 0; n < 2; ++n) _Pragma("unroll") for (int k = 0; k < 2; ++k) dst[n][k] = *(const PG8_LAS bf16x8*)(lds + PG8_SB(b, h) + boff + n * 2048 + k * 1024); } while (0)
#define PG8_MMA(ai, bj, At, Bt) do { __builtin_amdgcn_s_setprio(1); _Pragma("unroll") for (int m = 0; m < 4; ++m) _Pragma("unroll") for (int n = 0; n < 2; ++n) _Pragma("unroll") for (int k = 0; k < 2; ++k) \
        acc[ai][bj][m][n] = __builtin_amdgcn_mfma_f32_16x16x32_bf16(Bt[n][k], At[m][k], acc[ai][bj][m][n], 0, 0, 0); __builtin_amdgcn_s_setprio(0); } while (0)
#define PG8_WAIT_V(n) asm volatile("s_waitcnt vmcnt(" #n ")" ::: "memory")
#define PG8_WAIT_L(n) asm volatile("s_waitcnt lgkmcnt(" #n ")" ::: "memory")
#define PG8_WAIT_VR asm volatile("s_waitcnt vmcnt(%0)" :: "n"(8 + Epi::NVM) : "memory")
#define PG8_BAR __builtin_amdgcn_s_barrier()
#define PG8_SCHED __builtin_amdgcn_sched_barrier(0)
    Unit cur, nxt; int ui = 0;
    if (!S.next(0, cur)) return;
    f32x4 acc[2][2][4][2];
#pragma unroll
    for (int a = 0; a < 2; ++a)
#pragma unroll
        for (int b = 0; b < 2; ++b)
#pragma unroll
            for (int m = 0; m < 4; ++m)
#pragma unroll
                for (int n = 0; n < 2; ++n) acc[a][b][m][n] = (f32x4){0.f, 0.f, 0.f, 0.f};
    bf16x8 At[4][2], B0[2][2], B1[2][2];
    const char* cA = (const char*)g.A + (size_t)cur.pm * tstep; const char* cB = (const char*)g.Bt + (size_t)cur.pn * tstep;
    S.a_ready(cur);
    if constexpr (SP2) {
        PG8_STAGE(PG8_SB(0, 0), cB, voffB); PG8_STAGE(PG8_SB(0, 1), cB + hstep, voffB); PG8_STAGE(PG8_SA(0, 0), cA, voffA); PG8_STAGE(PG8_SA(0, 1), cA + hstep, voffA);
        if (wr == 1) PG8_BAR;
        PG8_WAIT_V(2); PG8_BAR;
        PG8_STAGE(PG8_SB(1, 0), cB + kstep, voffB); PG8_STAGE(PG8_SA(1, 0), cA + kstep, voffA); PG8_STAGE(PG8_SB(1, 1), cB + hstep + kstep, voffB);
        PG8_WAIT_V(6); PG8_BAR;
    } else {
        PG8_STAGE(PG8_SB(0, 0), cB, voffB); PG8_STAGE(PG8_SA(0, 0), cA, voffA); PG8_STAGE(PG8_SB(0, 1), cB + hstep, voffB); PG8_STAGE(PG8_SA(0, 1), cA + hstep, voffA);
        if (wr == 1) PG8_BAR;
        PG8_WAIT_V(4); PG8_BAR;
        PG8_STAGE(PG8_SB(1, 0), cB + kstep, voffB); PG8_STAGE(PG8_SA(1, 0), cA + kstep, voffA); PG8_STAGE(PG8_SB(1, 1), cB + hstep + kstep, voffB);
        PG8_WAIT_V(6); PG8_BAR;
    }
    bool relax = false;
    for (;;) {
        const bool has_next = S.next((ui + 1) >> 1, nxt);
        const Gemm& gn = ((ui + 1) & 1) ? g2 : g;
        const char* nA = has_next ? (const char*)gn.A + (size_t)nxt.pm * tstep : cA; const char* nB = has_next ? (const char*)gn.Bt + (size_t)nxt.pn * tstep : cB;
#pragma unroll
        for (int a = 0; a < 2; ++a)
#pragma unroll
            for (int b = 0; b < 2; ++b)
#pragma unroll
                for (int m = 0; m < 4; ++m)
#pragma unroll
                    for (int n = 0; n < 2; ++n) asm volatile("" : "+v"(acc[a][b][m][n]));
        if constexpr (SP2) {
#define PG8_KITER(t, WVA, STG1) do { \
            const bool last = ((t) == nt - 2); \
            const char* a1 = cA + (size_t)((t) + 1) * kstep;                                           \
            const char* a2 = last ? nA : cA + (size_t)((t) + 2) * kstep; const char* b2 = last ? nB : cB + (size_t)((t) + 2) * kstep;     \
            const char* a3 = a2 + kstep; const char* b3 = b2 + kstep;                                \
            if (last && has_next) S.a_ready(nxt); \
              \
            PG8_LDB(B0, 0, 0); PG8_LDB(B1, 0, 1); PG8_SCHED; PG8_LDA(At, 0, 0); STG1; \
            WVA; PG8_WAIT_L(0); PG8_BAR; PG8_MMA(0, 0, At, B0); PG8_MMA(0, 1, At, B1); PG8_BAR; PG8_SCHED; \
              \
            PG8_LDA(At, 0, 1); PG8_STAGE(PG8_SB(0, 0), b2, voffB); PG8_STAGE(PG8_SB(0, 1), b2 + hstep, voffB); PG8_STAGE(PG8_SA(0, 0), a2, voffA); \
            WVA; PG8_WAIT_L(0); PG8_BAR; PG8_MMA(1, 0, At, B0); PG8_MMA(1, 1, At, B1); PG8_BAR; PG8_SCHED; \
              \
            PG8_LDB(B0, 1, 0); PG8_LDB(B1, 1, 1); PG8_SCHED; PG8_LDA(At, 1, 0); PG8_STAGE(PG8_SA(0, 1), a2 + hstep, voffA); \
            WVA; PG8_WAIT_L(0); PG8_BAR; PG8_MMA(0, 0, At, B0); PG8_MMA(0, 1, At, B1); PG8_BAR; PG8_SCHED; \
              \
            PG8_LDA(At, 1, 1); PG8_STAGE(PG8_SB(1, 0), b3, voffB); PG8_STAGE(PG8_SB(1, 1), b3 + hstep, voffB); PG8_STAGE(PG8_SA(1, 0), a3, voffA); \
            PG8_WAIT_V(8); PG8_WAIT_L(0); PG8_BAR; PG8_MMA(1, 0, At, B0); PG8_MMA(1, 1, At, B1); PG8_BAR; PG8_SCHED; } while (0)
            int t = 0;
            if (relax) { PG8_KITER(0, PG8_WAIT_VR, (void)0); t = 2; }
#pragma unroll 1
            for (; t < nt; t += 2) PG8_KITER(t, PG8_WAIT_V(8), PG8_STAGE(PG8_SA(1, 1), a1 + hstep, voffA));
#undef PG8_KITER
        } else {
        for (int t = 0; t < nt; t += 2) {
            const bool last = (t == nt - 2);
            const char* a1 = cA + (size_t)(t + 1) * kstep;
            const char* a2 = last ? nA : cA + (size_t)(t + 2) * kstep; const char* b2 = last ? nB : cB + (size_t)(t + 2) * kstep;
            const char* a3 = a2 + kstep; const char* b3 = b2 + kstep;
            if (last && has_next) S.a_ready(nxt);
            PG8_LDB(B0, 0, 0); PG8_SCHED; PG8_LDA(At, 0, 0); PG8_STAGE(PG8_SA(1, 1), a1 + hstep, voffA);
            PG8_WAIT_L(8); PG8_BAR; PG8_WAIT_L(0); PG8_MMA(0, 0, At, B0); PG8_BAR; PG8_SCHED;
            PG8_LDB(B1, 0, 1); PG8_STAGE(PG8_SB(0, 0), b2, voffB);
            PG8_BAR; PG8_WAIT_L(0); PG8_MMA(0, 1, At, B1); PG8_BAR;
            PG8_LDA(At, 0, 1); PG8_STAGE(PG8_SA(0, 0), a2, voffA);
            PG8_BAR; PG8_WAIT_L(0); PG8_MMA(1, 0, At, B0); PG8_BAR; PG8_SCHED;
            PG8_STAGE(PG8_SB(0, 1), b2 + hstep, voffB);
            PG8_WAIT_V(6); PG8_BAR; PG8_MMA(1, 1, At, B1); PG8_BAR;
            PG8_LDB(B0, 1, 0); PG8_SCHED; PG8_LDA(At, 1, 0); PG8_STAGE(PG8_SA(0, 1), a2 + hstep, voffA);
            PG8_WAIT_L(8); PG8_BAR; PG8_WAIT_L(0); PG8_MMA(0, 0, At, B0); PG8_BAR; PG8_SCHED;
            PG8_LDB(B1, 1, 1); PG8_STAGE(PG8_SB(1, 0), b3, voffB);
            PG8_BAR; PG8_WAIT_L(0); PG8_MMA(0, 1, At, B1); PG8_BAR;
            PG8_LDA(At, 1, 1); PG8_STAGE(PG8_SA(1, 0), a3, voffA);
            PG8_BAR; PG8_WAIT_L(0); PG8_MMA(1, 0, At, B0); PG8_BAR; PG8_SCHED;
            PG8_STAGE(PG8_SB(1, 1), b3 + hstep, voffB);
            PG8_WAIT_V(6); PG8_BAR; PG8_MMA(1, 1, At, B1); PG8_BAR;
        }
        }
        if constexpr (ALIGN_EPI) { if (wr == 0) PG8_BAR; }
        if constexpr (SP2 && !Epi::AFTER_DRAIN) { if (has_next) { PG8_STAGE(PG8_SA(1, 1), nA + kstep + hstep, voffA); relax = true; } }
        if constexpr (!Epi::AFTER_DRAIN) {
            const int tz = opaque_tid(), widz = __builtin_amdgcn_readfirstlane(tz >> 6), lanez = tz & 63, wrz = widz >> 2, wcz = widz & 3, frz = lanez & 15, fqz = lanez >> 4;
            if (ui & 1) E(acc, cur, wrz, wcz, frz, fqz); else E.mid(acc, cur, wrz, wcz, frz, fqz);
            S.done(cur); }
        if (!has_next) break;
        if (ui & 1) {
#pragma unroll
            for (int a = 0; a < 2; ++a)
#pragma unroll
                for (int b = 0; b < 2; ++b)
#pragma unroll
                    for (int m = 0; m < 4; ++m)
#pragma unroll
                        for (int n = 0; n < 2; ++n) acc[a][b][m][n] = (f32x4){0.f, 0.f, 0.f, 0.f};
        }
        cur = nxt; cA = nA; cB = nB; ++ui; nt = (ui & 1) ? nt2 : nt1;
        if constexpr (ALIGN_EPI) { if (wr == 1) PG8_BAR; }
    }
    PG8_WAIT_V(0);
    if constexpr (!ALIGN_EPI) { if (wr == 0) PG8_BAR; }
    PG8_BAR;
    if constexpr (Epi::AFTER_DRAIN) { E.fused(acc, cur, wr, wc, fr, fq, lds, wid, lane); S.done(cur); }
#undef PG8_SA
#undef PG8_SB
#undef PG8_STAGE
#undef PG8_LDA
#undef PG8_LDB
#undef PG8_MMA
#undef PG8_WAIT_V
#undef PG8_WAIT_L
#undef PG8_WAIT_VR
#undef PG8_BAR
#undef PG8_SCHED
}
}
#define GAS __attribute__((address_space(1)))
#define LAS __attribute__((address_space(3)))
typedef unsigned short bf16;
typedef unsigned v4u __attribute__((ext_vector_type(4)));
typedef float f32x4 __attribute__((ext_vector_type(4)));
typedef short bf16x8 __attribute__((ext_vector_type(8)));
typedef GAS unsigned gu32;
typedef GAS unsigned long long gu64;
#define RLX_AGENT __ATOMIC_RELAXED, __HIP_MEMORY_SCOPE_AGENT
#define LDS_WAIT() asm volatile("s_waitcnt lgkmcnt(0)" ::: "memory")
#define VM_WAIT() asm volatile("s_waitcnt vmcnt(0)" ::: "memory")
__device__ __forceinline__ unsigned long long rt() { return __builtin_amdgcn_s_memrealtime(); }
__device__ __forceinline__ unsigned f2bf(float f) { unsigned u = __builtin_bit_cast(unsigned, f); return (u + 0x7fffu + ((u >> 16) & 1u)) >> 16; }
__device__ __forceinline__ unsigned pk2(float lo, float hi) { return f2bf(lo) | (f2bf(hi) << 16); }
#define XB_TMO      128
#define XB_XCNT(j)  (256  + 64 * (j))
#define XB_XSUB(j)  (1280 + 64 * (j))
#define XB_XGEN(j)  (2304 + 64 * (j))
#define XB_TOP      3328
#define XB_TOPGEN   3392
#define XCD_BAR_WORDS 3456
#define XB_SPIN_CAP (1u << 18)

__device__ __forceinline__ unsigned xb_ld(unsigned* p)              { return __hip_atomic_load(p, __ATOMIC_RELAXED, __HIP_MEMORY_SCOPE_AGENT); }
__device__ __forceinline__ unsigned xb_add(unsigned* p, unsigned v) { return __hip_atomic_fetch_add(p, v, __ATOMIC_RELAXED, __HIP_MEMORY_SCOPE_AGENT); }
__device__ __forceinline__ unsigned xb_xcc_id() { return (unsigned)__builtin_amdgcn_s_getreg((3 << 11) | 20) & 0xFu; }
#define XB_SPIN(cond, bar) do { unsigned _sp = 0; while (cond) { __builtin_amdgcn_s_sleep(1); \
    if ((++_sp & 255u) == 0u) { if (xb_ld(&(bar)[XB_TMO])) break; if (_sp > XB_SPIN_CAP) { atomicAdd(&(bar)[XB_TMO], 1u); break; } } } } while (0)

struct XcdBarrier {
    unsigned* bar; unsigned x;
    volatile LAS unsigned* st;
};

__device__ __forceinline__ XcdBarrier xcd_barrier_post(unsigned* bar, volatile LAS unsigned* st) {
    XcdBarrier b; b.bar = bar; b.x = xb_xcc_id(); b.st = st;
    if (threadIdx.x == 0) (void)xb_add(&bar[XB_XCNT(b.x)], 1u);
    return b;
}
__device__ __forceinline__ void xcd_barrier_complete(unsigned* bar, unsigned x, unsigned& nloc, unsigned& nx) {
    const unsigned G = gridDim.x * gridDim.y * gridDim.z;
    unsigned sum, cnt, mine, sp = 0u;
    for (;;) {
        sum = 0u; cnt = 0u; mine = 0u;
#pragma unroll
        for (unsigned j = 0; j < 16; ++j) { const unsigned c = xb_ld(&bar[XB_XCNT(j)]); sum += c; cnt += (c > 0u) ? 1u : 0u; mine = (j == x) ? c : mine; }
        if (sum == G) break;
        __builtin_amdgcn_s_sleep(1);
        if ((++sp & 255u) == 0u) { if (xb_ld(&bar[XB_TMO])) break; if (sp > XB_SPIN_CAP) { atomicAdd(&bar[XB_TMO], 1u); break; } }
    }
    nloc = mine > 0u ? mine : 1u; nx = cnt > 0u ? cnt : 1u;
}

__device__ __forceinline__ void xcd_barrier(const XcdBarrier& b) {
    asm volatile("s_waitcnt vmcnt(0)" ::: "memory");
    __syncthreads();
    if (threadIdx.x == 0) {
        unsigned* bar = b.bar;
        __builtin_amdgcn_s_waitcnt(0);
        unsigned nloc = b.st[0], nx = b.st[1];
        if (nloc == 0u) { xcd_barrier_complete(bar, b.x, nloc, nx); b.st[0] = nloc; b.st[1] = nx; }
        const unsigned old = xb_add(&bar[XB_XSUB(b.x)], 1u);
        const unsigned gen = old / nloc;
        if (old + 1u == (gen + 1u) * nloc) {
            __builtin_amdgcn_fence(__ATOMIC_RELEASE, "agent");
            asm volatile("s_waitcnt vmcnt(0)" ::: "memory");
            const unsigned og = xb_add(&bar[XB_TOP], 1u);
            const unsigned tg = og / nx;
            if (og + 1u == (tg + 1u) * nx) xb_add(&bar[XB_TOPGEN], 1u);
            else XB_SPIN(xb_ld(&bar[XB_TOPGEN]) == tg, bar);
            __builtin_amdgcn_fence(__ATOMIC_ACQUIRE, "agent");
            xb_add(&bar[XB_XGEN(b.x)], 1u);
            asm volatile("s_waitcnt vmcnt(0)" ::: "memory");
        } else {
            XB_SPIN(xb_ld(&bar[XB_XGEN(b.x)]) == gen, bar);
            __builtin_amdgcn_fence(__ATOMIC_ACQUIRE, "agent");
            asm volatile("s_waitcnt vmcnt(0)" ::: "memory");
        }
    }
    __syncthreads();
}

constexpr int DM = 2048, DFF = 5504, NFF2 = 11008, NIN = 11264, NMODC = 18432;
constexpr int MC = 8192, MS = 16384, M = 24576, TCX = 256, TSM = 2048, PAST = 512, KVS = 2560;
constexpr int KVROWS = MC + 8 * KVS;
constexpr float NORM_EPS = 1e-6f;
constexpr int NPHASE = 27;
constexpr int NWAVES = 8;

constexpr size_t MiB = 1u << 20;
constexpr size_t WS_CTL = 0, CTL_ZERO_BYTES = 1 * MiB;
constexpr size_t WS_MODP = 1 * MiB;
constexpr size_t WS_MOD = 22 * MiB;
constexpr size_t WS_ROPE = 24 * MiB;
constexpr size_t WS_W1T = 25 * MiB;
constexpr size_t WS_W2T = 111 * MiB;
constexpr size_t WS_WINT = 154 * MiB;
constexpr size_t WS_PLRUT = 198 * MiB;
constexpr size_t WS_PATTNT = (686 + 96) * MiB;
constexpr size_t WS_WOUTT = 210 * MiB;
constexpr size_t WS_WG = 218 * MiB;
constexpr size_t WS_KB = 220 * MiB;
constexpr size_t WS_VB = 276 * MiB;
constexpr size_t WS_H = 332 * MiB;
constexpr size_t WS_R1 = 428 * MiB;
constexpr size_t WS_R2 = 686 * MiB;
constexpr size_t WS_GM = 878 * MiB;
constexpr size_t WS_HF = 1070 * MiB;
constexpr size_t WS_HB = 1166 * MiB;
constexpr size_t WS_X16 = 1262 * MiB;
constexpr size_t WS_END = 1358 * MiB;
constexpr int CW_BAR = 4096;

constexpr int RING_BYTES = 131072;
constexpr int LDSCTL_OFF = RING_BYTES, MISC_OFF = LDSCTL_OFF + 320;
constexpr int LDS_BYTES = 147456;
constexpr int PTAB_OFF = LDSCTL_OFF + 1024;

typedef _Float16 h16x4 __attribute__((ext_vector_type(4)));
__device__ __forceinline__ float wave_sum(float v) {
#pragma unroll
    for (int o = 1; o < 64; o <<= 1) v += __shfl_xor(v, o);
    return v;
}
__device__ __forceinline__ unsigned cvtpk(float lo, float hi) { return pg8::cvt_pk_bf16(lo, hi); }
__device__ __forceinline__ float bflo(unsigned w) { return __uint_as_float(w << 16); }
__device__ __forceinline__ float bfhi(unsigned w) { return __uint_as_float(w & 0xffff0000u); }

struct Ptrs {
    const volatile LAS unsigned* tab; float* out; unsigned char* ws;
    __device__ __forceinline__ const float* in(int i) const { const unsigned lo = (unsigned)__builtin_amdgcn_readfirstlane((int)tab[2 * i]), hi = (unsigned)__builtin_amdgcn_readfirstlane((int)tab[2 * i + 1]);
        return (const float*)(const GAS float*)(((unsigned long long)hi << 32) | lo); }
};
struct CwItem { const float* src; bf16* dst; int N, K, k0, n0, drow0, pm; };
__device__ __forceinline__ CwItem cw_decode(const Ptrs& P, int l, int it) {
    bf16* W1T = (bf16*)(P.ws + WS_W1T); bf16* W2T = (bf16*)(P.ws + WS_W2T); bf16* WINT = (bf16*)(P.ws + WS_WINT);
    bf16* PLT = (bf16*)(P.ws + WS_PLRUT); bf16* PAT = (bf16*)(P.ws + WS_PATTNT); bf16* WOT = (bf16*)(P.ws + WS_WOUTT); bf16* WG = (bf16*)(P.ws + WS_WG);
    constexpr int I_W1 = 2 * 32 * 344, I_W2 = 2 * 86 * 64, I_WIN = 32 * 352, I_PL = 32 * 64, I_PA = 16 * 64, I_WO = 32 * 64;
    CwItem c; int r = it; c.pm = 0;
    if (r < I_W1) { const int f = r / 11008, r2 = r % 11008, kb = r2 / 344, nb = r2 % 344, n0 = 32 * nb, isu = n0 / DFF, j0 = n0 % DFF;
        c.src = P.in(11) + (size_t)(l * 2 + f) * DM * NFF2; c.N = NFF2; c.k0 = 64 * kb; c.n0 = n0; c.dst = W1T + (size_t)f * NFF2 * DM; c.K = DM; c.drow0 = (j0 >> 7) * 256 + isu * 128 + (j0 & 127); return c; }
    r -= I_W1;
    if (r < I_W2) { const int f = r / 5504, r2 = r % 5504, kb = r2 / 64, nb = r2 % 64;
        c.src = P.in(12) + (size_t)(l * 2 + f) * DFF * DM; c.N = DM; c.k0 = 64 * kb; c.n0 = 32 * nb; c.dst = W2T + (size_t)f * DM * DFF; c.K = DFF; c.drow0 = 32 * nb; return c; }
    r -= I_W2;
    if (r < I_WIN) { const int kb = r / 352, nb = r % 352;
        c.src = P.in(13) + (size_t)l * DM * NIN; c.N = NIN; c.k0 = 64 * kb; c.n0 = 32 * nb; c.dst = WINT; c.K = DM; c.drow0 = 32 * nb; c.pm = (nb >= 128 && nb < 192) ? 1 : 0; return c; }
    r -= I_WIN;
    if (r < I_PL) { const int kb = r / 64, nb = r % 64;
        c.src = P.in(26) + (size_t)l * DM * DM; c.N = DM; c.k0 = 64 * kb; c.n0 = 32 * nb; c.dst = PLT; c.K = DM; c.drow0 = 32 * nb; return c; }
    r -= I_PL;
    if (r < I_PA) { const int kb = r / 64, nb = r % 64;
        c.src = P.in(27) + (size_t)l * 1024 * DM; c.N = DM; c.k0 = 64 * kb; c.n0 = 32 * nb; c.dst = PAT; c.K = DM  ; c.drow0 = 32 * nb; return c; }
    r -= I_PA;
    if (r < I_WO) { const int kb = r / 64, nb = r % 64;
        c.src = P.in(28) + (size_t)l * DM * DM; c.N = DM; c.k0 = 64 * kb; c.n0 = 32 * nb; c.dst = WOT; c.K = DM; c.drow0 = 32 * nb; return c; }
    r -= I_WO;
    { const int mat = r >> 7, g = mat >> 1, dir = mat & 1, r2 = r & 127, n = r2 >> 3, r3 = r2 & 7, kb = r3 >> 2, nb = r3 & 3;
      c.src = (g ? P.in(18) : P.in(16)) + (size_t)((l * 2 + dir) * 16 + n) * 16384; c.N = 128; c.k0 = 64 * kb; c.n0 = 32 * nb; c.dst = WG + (size_t)((n * 2 + dir) * 2 + g) * 16384; c.K = 128; c.drow0 = 32 * nb; }
    return c;
}
constexpr int CW_NIT = 2 * 32 * 344 + 2 * 86 * 64 + 32 * 352 + 32 * 64 + 16 * 64 + 32 * 64 + 512;
__device__ __forceinline__ void convert_weights(const Ptrs& P, int l, LAS unsigned char* lds, int it0, int stride, int itend, int wave, int lane) {
    LAS float* scr = (LAS float*)(lds + wave * 16384);
    const int gw = it0, NGW = stride, NIT = itend;
    if (gw >= NIT) return;
    f32x4 tv[8];
#define CW_LOAD(c_) do { _Pragma("unroll") for (int i_ = 0; i_ < 8; ++i_) tv[i_] = *(const GAS f32x4*)((c_).src + (size_t)((c_).k0 + 8 * i_ + (lane >> 3)) * (c_).N + (c_).n0 + 4 * (lane & 7)); } while (0)
    CwItem cur = cw_decode(P, l, gw);
    CW_LOAD(cur);
    for (int it = gw; it < NIT; it += NGW) {
#pragma unroll
        for (int i = 0; i < 8; ++i) { LAS float* d = scr + (8 * i + (lane >> 3)) * 33 + 4 * (lane & 7); d[0] = tv[i][0]; d[1] = tv[i][1]; d[2] = tv[i][2]; d[3] = tv[i][3]; }
        LDS_WAIT(); asm volatile("" ::: "memory");
        const CwItem done = cur;
        if (it + NGW < NIT) { cur = cw_decode(P, l, it + NGW); CW_LOAD(cur); }
        const int c = lane & 7;
#pragma unroll
        for (int j = 0; j < 4; ++j) { const int n = (lane >> 3) + 8 * j; const LAS float* sp = scr + (8 * c) * 33 + n;
            v4u o; o.x = cvtpk(sp[0 * 33], sp[1 * 33]); o.y = cvtpk(sp[2 * 33], sp[3 * 33]); o.z = cvtpk(sp[4 * 33], sp[5 * 33]); o.w = cvtpk(sp[6 * 33], sp[7 * 33]);
            *(GAS v4u*)(done.dst + (size_t)(done.drow0 + (done.pm ? pg8::perm32(n) : n)) * done.K + done.k0 + 8 * c) = o; }
        LDS_WAIT(); asm volatile("" ::: "memory");
    }
#undef CW_LOAD
}
__device__ __forceinline__ void mod_partials(const Ptrs& P, LAS unsigned char* lds, int gw, int NGW, int wave, int lane) {
    LAS float* scr = (LAS float*)(lds + wave * 16384);
    float* modp = (float*)(P.ws + WS_MODP);
    const float* cvec = P.in(2); const float* cctx = P.in(6); const float* wmod = P.in(7);
    for (int it = gw; it < 2 * 72 * 16; it += NGW) {
        const int kc = it & 15, rest = it >> 4, nb = rest % 72, l = rest / 72, k0 = kc * 128;
        for (int idx = lane; idx < 128 * 9; idx += 64) { const int k = idx / 9, r = idx - 9 * k;
            const float x = (r == 0) ? cctx[k0 + k] : cvec[(r - 1) * DM + k0 + k]; scr[k * 12 + r] = x / (1.0f + expf(-x)); }
        LDS_WAIT(); asm volatile("" ::: "memory");
        const GAS f32x4* wp = (const GAS f32x4*)(wmod + ((size_t)l * DM + k0) * NMODC + nb * 256) + lane;
        f32x4 acc[9];
#pragma unroll
        for (int r = 0; r < 9; ++r) acc[r] = (f32x4){0.f, 0.f, 0.f, 0.f};
#pragma unroll 1
        for (int kg = 0; kg < 128; kg += 16) {
            f32x4 w16[16];
#pragma unroll
            for (int j = 0; j < 16; ++j) w16[j] = wp[(size_t)(kg + j) * (NMODC / 4)];
#pragma unroll
            for (int j = 0; j < 16; ++j) { const int k = kg + j; const f32x4 w = w16[j];
                const f32x4 s0 = *(const LAS f32x4*)(scr + k * 12), s1 = *(const LAS f32x4*)(scr + k * 12 + 4); const float s2 = scr[k * 12 + 8];
                acc[0] += w * s0[0]; acc[1] += w * s0[1]; acc[2] += w * s0[2]; acc[3] += w * s0[3];
                acc[4] += w * s1[0]; acc[5] += w * s1[1]; acc[6] += w * s1[2]; acc[7] += w * s1[3]; acc[8] += w * s2; }
        }
#pragma unroll
        for (int r = 0; r < 9; ++r) *(GAS f32x4*)(modp + ((size_t)(kc * 2 + l) * 9 + r) * NMODC + nb * 256 + 4 * lane) = acc[r];
        LDS_WAIT(); asm volatile("" ::: "memory");
    }
}
__device__ __forceinline__ void mod_reduce(const Ptrs& P, int gtid, int NT) {
    const float* modp = (const float*)(P.ws + WS_MODP); float* mod = (float*)(P.ws + WS_MOD); const float* bmod = P.in(8);
    for (int i = gtid; i < 2 * 9 * (NMODC / 4); i += NT) {
        const int n4 = i % (NMODC / 4), lr = i / (NMODC / 4), l = lr / 9;
        f32x4 s = *(const GAS f32x4*)(bmod + (size_t)l * NMODC + 4 * n4);
#pragma unroll
        for (int kc = 0; kc < 16; ++kc) s += *(const GAS f32x4*)(modp + ((size_t)kc * 18 + lr) * NMODC + 4 * n4);
        *(GAS f32x4*)(mod + (size_t)lr * NMODC + 4 * n4) = s;
    }
}
__device__ __forceinline__ void convert_cache(const Ptrs& P, int l, int gtid, int NT) {
    bf16* KB = (bf16*)(P.ws + WS_KB); bf16* VB = (bf16*)(P.ws + WS_VB);
    for (int i = gtid; i < 2 * 4096 * 128; i += NT) {
        const int tens = i >> 19, j = i & ((1 << 19) - 1), row = j >> 7, ch = j & 127, b = row >> 9, p = row & 511;
        const float* src = (tens ? P.in(4) : P.in(3)) + ((size_t)(b * 2 + l) * 512 + p) * 1024 + ch * 8;
        bf16* dst = (tens ? VB : KB) + (size_t)(MC + b * KVS + p) * 1024 + ch * 8;
        const f32x4 a = *(const GAS f32x4*)src, c = *(const GAS f32x4*)(src + 4);
        v4u o; o.x = cvtpk(a[0], a[1]); o.y = cvtpk(a[2], a[3]); o.z = cvtpk(c[0], c[1]); o.w = cvtpk(c[2], c[3]);
        *(GAS v4u*)dst = o;
    }
}

__device__ __forceinline__ void thin_phase(LAS unsigned char* lds, int bid, int tid, int lane, int wave, int G,
                                           const float* xsrc_c, const float* xsrc_s, const _Float16* X16in, _Float16* X16out, float* Xf32out, const bf16* D, bf16* H,
                                           const float* gpost, const float* mod_res, int gt_chunk, float gscale, bool has_res,
                                           const float* gpre, const float* mod_next, int sc_chunk, int sh_chunk, bool has_next) {
    LAS f32x4* v1 = (LAS f32x4*)lds; LAS f32x4* v2 = (LAS f32x4*)(lds + 8192); LAS f32x4* v3 = (LAS f32x4*)(lds + 16384);
    for (int c = bid; c < M / 32; c += G) {
        const int r = (c < 256) ? 0 : 1 + ((c - 256) >> 6);
        __syncthreads();
        {
            f32x4 a = (f32x4){0.f, 0.f, 0.f, 0.f}, b2 = a, b3 = a;
            if (has_res) { a = *(const GAS f32x4*)(mod_res + (size_t)r * NMODC + gt_chunk * DM + 4 * tid) * *(const GAS f32x4*)(gpost + 4 * tid) * gscale; }
            if (has_next) { b2 = *(const GAS f32x4*)(gpre + 4 * tid) * (*(const GAS f32x4*)(mod_next + (size_t)r * NMODC + sc_chunk * DM + 4 * tid) + 1.0f);
                            b3 = *(const GAS f32x4*)(mod_next + (size_t)r * NMODC + sh_chunk * DM + 4 * tid); }
            v1[tid] = a; v2[tid] = b2; v3[tid] = b3;
        }
        __syncthreads();
        h16x4 xr[8]; unsigned long long dr[8]; f32x4 xf[8];
#define THIN_LOAD(m_) do { if (X16in) { _Pragma("unroll") for (int j_ = 0; j_ < 8; ++j_) xr[j_] = *((const GAS h16x4*)(X16in + (size_t)(m_) * DM) + lane + 64 * j_); } \
            else { const float* xrow_ = ((m_) < MC) ? xsrc_c + (size_t)(m_) * DM : xsrc_s + (size_t)((m_) - MC) * DM; _Pragma("unroll") for (int j_ = 0; j_ < 8; ++j_) xf[j_] = *((const GAS f32x4*)xrow_ + lane + 64 * j_); } \
            if (has_res) { _Pragma("unroll") for (int j_ = 0; j_ < 8; ++j_) dr[j_] = *((const GAS unsigned long long*)(D + (size_t)(m_) * DM) + lane + 64 * j_); } } while (0)
        THIN_LOAD(c * 32 + wave * 4);
#pragma unroll 1
        for (int i = 0; i < 4; ++i) {
            const int m = c * 32 + wave * 4 + i;
            f32x4 x[8], d[8];
            if (X16in) {
#pragma unroll
                for (int j = 0; j < 8; ++j) x[j] = (f32x4){(float)xr[j][0], (float)xr[j][1], (float)xr[j][2], (float)xr[j][3]};
            } else {
#pragma unroll
                for (int j = 0; j < 8; ++j) x[j] = xf[j];
            }
            if (has_res) {
#pragma unroll
                for (int j = 0; j < 8; ++j) { const unsigned long long dw = dr[j]; d[j][0] = bflo((unsigned)dw); d[j][1] = bfhi((unsigned)dw); d[j][2] = bflo((unsigned)(dw >> 32)); d[j][3] = bfhi((unsigned)(dw >> 32)); }
            }
            asm volatile("" ::: "memory");
            if (i < 3) THIN_LOAD(m + 1);
            if (has_res) {
                float s = 0.f;
#pragma unroll
                for (int j = 0; j < 8; ++j) s += (d[j][0] * d[j][0] + d[j][1] * d[j][1]) + (d[j][2] * d[j][2] + d[j][3] * d[j][3]);
                const float rstd = 1.0f / sqrtf(wave_sum(s) * (1.0f / DM) + NORM_EPS);
#pragma unroll
                for (int j = 0; j < 8; ++j) x[j] += v1[lane + 64 * j] * d[j] * rstd;
            }
            if (Xf32out) {
#pragma unroll
                for (int j = 0; j < 8; ++j) *((GAS f32x4*)(Xf32out + (size_t)m * DM) + lane + 64 * j) = x[j];
            } else {
#pragma unroll
                for (int j = 0; j < 8; ++j) { h16x4 hv; hv[0] = (_Float16)x[j][0]; hv[1] = (_Float16)x[j][1]; hv[2] = (_Float16)x[j][2]; hv[3] = (_Float16)x[j][3]; *((GAS h16x4*)(X16out + (size_t)m * DM) + lane + 64 * j) = hv; }
            }
            if (has_next) {
                float s = 0.f;
#pragma unroll
                for (int j = 0; j < 8; ++j) s += (x[j][0] * x[j][0] + x[j][1] * x[j][1]) + (x[j][2] * x[j][2] + x[j][3] * x[j][3]);
                const float rstd = 1.0f / sqrtf(wave_sum(s) * (1.0f / DM) + NORM_EPS);
#pragma unroll
                for (int j = 0; j < 8; ++j) { const f32x4 h = x[j] * rstd * v2[lane + 64 * j] + v3[lane + 64 * j];
                    *((GAS unsigned long long*)(H + (size_t)m * DM) + lane + 64 * j) = (unsigned long long)cvtpk(h[0], h[1]) | ((unsigned long long)cvtpk(h[2], h[3]) << 32); }
            }
        }
    }
#undef THIN_LOAD
    __syncthreads();
}

constexpr int LR_XS = 0, LR_XS_STRIDE = 272, LR_YB = 18688, LR_YB_STRIDE = 272, LR_Y32 = LR_YB + 17408, LR_F_STRIDE = 132  , LR_AS = LR_Y32 + 33792, LR_SEG = LR_AS + 33792, LR_HC = LR_SEG + 4096, LR_CW = LR_HC + 1024  , LR_END = LR_CW + 2560;
static_assert(LR_END <= RING_BYTES, "lru lds");
template <int MODE>
__device__ __forceinline__ void lru_phase(const Ptrs& P, int l, LAS unsigned char* lds, int bid, int tid, int lane, int wave, int G) {
    const bf16* XR = (const bf16*)(P.ws + WS_R1);
    const bf16* HBin = (const bf16*)(P.ws + WS_HB); const bf16* GG = (const bf16*)(P.ws + WS_R1 + 96 * MiB);
    const bf16* WG = (const bf16*)(P.ws + WS_WG);
    float* ostate = P.out + (size_t)M * DM + 4 * (size_t)MC * 1024;
    const int fr = lane & 15, fq = lane >> 4;
    const int nun = (G == 256) ? (bid < 128 ? 1 : 4) : 0;
    for (int ui = 0; ui < nun; ++ui) {
        int b, n, T, row0; bool samp; const int dir = (MODE == 1) ? 1 : 0;
        if (bid < 128) { samp = true; b = bid >> 4; n = bid & 15; T = TSM; row0 = MC + b * TSM; }
        else { const int uc = (bid - 128) * 4 + ui; samp = false; b = uc >> 4; n = uc & 15; T = TCX; row0 = b * TCX; }
        bf16* HO = (bf16*)(P.ws + (MODE == 1 ? WS_HB : WS_HF));
        const int ch0 = n * 128;
        pg8::bf16x8 wf[2][4];
        { const bf16* wb = WG + (size_t)((n * 2 + dir) * 2) * 16384;
#pragma unroll
          for (int g = 0; g < 2; ++g)
#pragma unroll
              for (int ks = 0; ks < 4; ++ks) wf[g][ks] = *(const GAS pg8::bf16x8*)(wb + (size_t)(g * 128 + wave * 16 + fr) * 128 + ks * 32 + fq * 8); }
        const int cch = ch0 + wave * 16 + fr;
        const float ba1 = P.in(17)[(size_t)(l * 2 + dir) * DM + cch] * -1.4426950408889634f, bx1 = P.in(19)[(size_t)(l * 2 + dir) * DM + cch] * -1.4426950408889634f;
        const float sp1 = -8.0f * 1.4426950408889634f * log1pf(expf(-P.in(20)[(size_t)(l * 2 + dir) * DM + cch]));
        float Hc = samp ? P.in(5)[(size_t)((b * 2 + l) * 2 + dir) * DM + cch] : 0.f;
        const int pos = dir ? 3 - fq : fq;
        const int la4 = lane * 4, prev1 = ((lane + (dir ? 16 : -16)) & 63) * 4, prev2 = ((lane + (dir ? 32 : -32)) & 63) * 4, totl = ((dir ? 0 : 48) + fr) * 4; (void)la4;
        const int cc = tid & 15;
        const int ntile = T >> 6;
        const int trow = tid >> 4;
        const LAS float* As = (const LAS float*)(lds + LR_AS); LAS float* Aw = (LAS float*)(lds + LR_AS); const LAS float* Ys = (const LAS float*)(lds + LR_Y32);
        v4u xp[3];
#define LRU_TILE(i_) (((dir ? (ntile - 1 - (i_)) : (i_))) << 6)
#define LRU_LOADX(t0_) do { _Pragma("unroll") for (int k_ = 0; k_ < 3; ++k_) { const int idx_ = tid + 512 * k_, t_ = (t0_) - 2 + (idx_ >> 4); xp[k_] = (v4u){0u, 0u, 0u, 0u}; \
        if (idx_ < 1072 && t_ >= 0 && t_ < T) xp[k_] = *(const GAS v4u*)(XR + (size_t)(row0 + t_) * DM + ch0 + (idx_ & 15) * 8); } } while (0)
#define LRU_PUTX() do { asm volatile("s_waitcnt vmcnt(0)" : "+v"(xp[0]), "+v"(xp[1]), "+v"(xp[2]) :: "memory");   \
        _Pragma("unroll") for (int k_ = 0; k_ < 3; ++k_) { const int idx_ = tid + 512 * k_; if (idx_ < 1072) *(LAS v4u*)(lds + LR_XS + (idx_ >> 4) * LR_XS_STRIDE + (idx_ & 15) * 16) = xp[k_]; } } while (0)
        LRU_LOADX(LRU_TILE(0)); LRU_PUTX();
        if (ntile > 1) LRU_LOADX(LRU_TILE(1));
        if (tid < 128) {
            LAS float* cwl = (LAS float*)(lds + LR_CW);
#pragma unroll
            for (int j = 0; j < 4; ++j) cwl[j * 128 + tid] = P.in(14)[(size_t)(l * 4 + j) * DM + ch0 + tid];
            cwl[512 + tid] = P.in(15)[(size_t)l * DM + ch0 + tid]; }
        __syncthreads();
#pragma unroll 1
        for (int it = 0; it < ntile; ++it) {
            const int t0 = LRU_TILE(it);
            v4u hbv[2], ggv[2];
            if (MODE == 2) {
#pragma unroll
                for (int k = 0; k < 2; ++k) { const size_t off = (size_t)(row0 + t0 + trow + 32 * k) * DM + ch0 + cc * 8; hbv[k] = *(const GAS v4u*)(HBin + off); ggv[k] = *(const GAS v4u*)(GG + off); }
            }
            float cw[4][8], cbias[8];
            { const LAS float* cwl = (const LAS float*)(lds + LR_CW) + cc * 8;
#pragma unroll
              for (int j = 0; j < 5; ++j) { const f32x4 a = *(const LAS f32x4*)(cwl + j * 128), c2 = *(const LAS f32x4*)(cwl + j * 128 + 4);
#pragma unroll
                  for (int e = 0; e < 4; ++e) { if (j < 4) { cw[j][e] = a[e]; cw[j][4 + e] = c2[e]; } else { cbias[e] = a[e]; cbias[4 + e] = c2[e]; } } } }
#pragma unroll
            for (int k = 0; k < 2; ++k) { const int tl = trow + 32 * k;
                float y[8];
#pragma unroll
                for (int e = 0; e < 8; ++e) y[e] = cbias[e];
#pragma unroll
                for (int j = 0; j < 4; ++j) { const v4u xv = *(const LAS v4u*)(lds + LR_XS + (tl + j) * LR_XS_STRIDE + cc * 16);
                    y[0] += cw[j][0] * bflo(xv.x); y[1] += cw[j][1] * bfhi(xv.x); y[2] += cw[j][2] * bflo(xv.y); y[3] += cw[j][3] * bfhi(xv.y);
                    y[4] += cw[j][4] * bflo(xv.z); y[5] += cw[j][5] * bfhi(xv.z); y[6] += cw[j][6] * bflo(xv.w); y[7] += cw[j][7] * bfhi(xv.w); }
                v4u o; o.x = cvtpk(y[0], y[1]); o.y = cvtpk(y[2], y[3]); o.z = cvtpk(y[4], y[5]); o.w = cvtpk(y[6], y[7]);
                *(LAS v4u*)(lds + LR_YB + tl * LR_YB_STRIDE + cc * 16) = o;
                LAS float* yf = (LAS float*)(lds + LR_Y32) + tl * LR_F_STRIDE + cc * 8;
                *(LAS f32x4*)yf = (f32x4){y[0], y[1], y[2], y[3]}; *(LAS f32x4*)(yf + 4) = (f32x4){y[4], y[5], y[6], y[7]}; }
            __syncthreads();
            {
                f32x4 ga[4], gx[4];
#pragma unroll
                for (int rb = 0; rb < 4; ++rb) { ga[rb] = (f32x4){0.f, 0.f, 0.f, 0.f}; gx[rb] = ga[rb]; }
#pragma unroll
                for (int kh = 0; kh < 2; ++kh) {
                    pg8::bf16x8 yfr[4][2];
#pragma unroll
                    for (int rb = 0; rb < 4; ++rb)
#pragma unroll
                        for (int k2 = 0; k2 < 2; ++k2) yfr[rb][k2] = *(const LAS pg8::bf16x8*)(lds + LR_YB + (rb * 16 + fr) * LR_YB_STRIDE + ((kh * 2 + k2) * 32 + fq * 8) * 2);
#pragma unroll
                    for (int k2 = 0; k2 < 2; ++k2)
#pragma unroll
                        for (int rb = 0; rb < 4; ++rb) { ga[rb] = __builtin_amdgcn_mfma_f32_16x16x32_bf16(yfr[rb][k2], wf[0][kh * 2 + k2], ga[rb], 0, 0, 0);
                                                         gx[rb] = __builtin_amdgcn_mfma_f32_16x16x32_bf16(yfr[rb][k2], wf[1][kh * 2 + k2], gx[rb], 0, 0, 0); }
                }
                float av[4][4], bv[4][4], SA[4], SB[4];
#pragma unroll
                for (int rb = 0; rb < 4; ++rb) {
#pragma unroll
                    for (int i = 0; i < 4; ++i) { const float yv = Ys[(rb * 16 + fq * 4 + i) * LR_F_STRIDE + wave * 16 + fr];
                        const float gta = __builtin_amdgcn_rcpf(1.0f + __builtin_amdgcn_exp2f(fmaf(ga[rb][i], -1.4426950408889634f, ba1))), gtx = __builtin_amdgcn_rcpf(1.0f + __builtin_amdgcn_exp2f(fmaf(gx[rb][i], -1.4426950408889634f, bx1)));
                        const float a = __builtin_amdgcn_exp2f(gta * sp1); av[rb][i] = a; bv[rb][i] = __builtin_amdgcn_sqrtf(fmaxf(fmaf(-a, a, 1.0f), 0.f)) * gtx * yv; }
                    float A = 1.f, B = 0.f;
#pragma unroll
                    for (int ii = 0; ii < 4; ++ii) { const int i = dir ? 3 - ii : ii; A = av[rb][i] * A; B = fmaf(av[rb][i], B, bv[rb][i]); }
                    SA[rb] = A; SB[rb] = B;
                }
#pragma unroll
                for (int rb = 0; rb < 4; ++rb) { const float pA = __int_as_float(__builtin_amdgcn_ds_bpermute(prev1, __float_as_int(SA[rb]))), pB = __int_as_float(__builtin_amdgcn_ds_bpermute(prev1, __float_as_int(SB[rb])));
                    if (pos >= 1) { SB[rb] = fmaf(SA[rb], pB, SB[rb]); SA[rb] = SA[rb] * pA; } }
#pragma unroll
                for (int rb = 0; rb < 4; ++rb) { const float pA = __int_as_float(__builtin_amdgcn_ds_bpermute(prev2, __float_as_int(SA[rb]))), pB = __int_as_float(__builtin_amdgcn_ds_bpermute(prev2, __float_as_int(SB[rb])));
                    if (pos >= 2) { SB[rb] = fmaf(SA[rb], pB, SB[rb]); SA[rb] = SA[rb] * pA; } }
                float Hin[4], he[4];
                {
                    float TA[4], TB[4];
#pragma unroll
                    for (int rb = 0; rb < 4; ++rb) { TA[rb] = __int_as_float(__builtin_amdgcn_ds_bpermute(totl, __float_as_int(SA[rb]))); TB[rb] = __int_as_float(__builtin_amdgcn_ds_bpermute(totl, __float_as_int(SB[rb]))); }
                    float H = Hc;
#pragma unroll
                    for (int q = 0; q < 4; ++q) { const int rb = dir ? 3 - q : q; Hin[rb] = H; H = fmaf(TA[rb], H, TB[rb]); }
                    Hc = H;
                }
#pragma unroll
                for (int rb = 0; rb < 4; ++rb) he[rb] = fmaf(SA[rb], Hin[rb], SB[rb]);
#pragma unroll
                for (int rb = 0; rb < 4; ++rb) { const float hp = __int_as_float(__builtin_amdgcn_ds_bpermute(prev1, __float_as_int(he[rb])));
                    float h = (pos == 0) ? Hin[rb] : hp;
#pragma unroll
                    for (int ii = 0; ii < 4; ++ii) { const int i = dir ? 3 - ii : ii; h = fmaf(av[rb][i], h, bv[rb][i]); Aw[(rb * 16 + fq * 4 + i) * LR_F_STRIDE + wave * 16 + fr] = h; } }
            }
            if (it + 1 < ntile) { LRU_PUTX(); if (it + 2 < ntile) LRU_LOADX(LRU_TILE(it + 2)); }
            __syncthreads();
            if (MODE == 2) {
                if (it + 1 < ntile) asm volatile("s_waitcnt vmcnt(3)" : "+v"(hbv[0]), "+v"(hbv[1]), "+v"(ggv[0]), "+v"(ggv[1]) :: "memory");
                else asm volatile("s_waitcnt vmcnt(0)" : "+v"(hbv[0]), "+v"(hbv[1]), "+v"(ggv[0]), "+v"(ggv[1]) :: "memory"); }
#pragma unroll
            for (int k = 0; k < 2; ++k) { const int tl = trow + 32 * k; const LAS float* hp = As + tl * LR_F_STRIDE + cc * 8;
                f32x4 a = *(const LAS f32x4*)hp, c2 = *(const LAS f32x4*)(hp + 4);
                if (MODE == 2) { const v4u q = hbv[k], g = ggv[k];
                    a[0] = (a[0] + bflo(q.x)) * bflo(g.x); a[1] = (a[1] + bfhi(q.x)) * bfhi(g.x); a[2] = (a[2] + bflo(q.y)) * bflo(g.y); a[3] = (a[3] + bfhi(q.y)) * bfhi(g.y);
                    c2[0] = (c2[0] + bflo(q.z)) * bflo(g.z); c2[1] = (c2[1] + bfhi(q.z)) * bfhi(g.z); c2[2] = (c2[2] + bflo(q.w)) * bflo(g.w); c2[3] = (c2[3] + bfhi(q.w)) * bfhi(g.w); }
                v4u o; o.x = cvtpk(a[0], a[1]); o.y = cvtpk(a[2], a[3]); o.z = cvtpk(c2[0], c2[1]); o.w = cvtpk(c2[2], c2[3]);
                *(GAS v4u*)(HO + (size_t)(row0 + t0 + tl) * DM + ch0 + cc * 8) = o; }
        }
#undef LRU_LOADX
#undef LRU_PUTX
#undef LRU_TILE
        if (!samp && fq == 0) ostate[(size_t)((b * 2 + l) * 2 + dir) * DM + cch] = Hc;
    }
    __syncthreads();
}

namespace att {
using bf16x8 = __attribute__((ext_vector_type(8))) short;
using s16x4  = __attribute__((ext_vector_type(4))) short;
using f32x16 = __attribute__((ext_vector_type(16))) float;
constexpr int NW = 8, QBLK = 32, KVBLK = 64, LDQ = 1024, LDK = 1024, LDO = 2048;
constexpr float SCALE = 0.125f, THR = 8.f;
constexpr int SHM_V = KVBLK * 128 * 2, SHM_K = KVBLK * 64 * 2, SHM_ATTN = 2 * SHM_V + 2 * SHM_K + NW * 64 * 4, STG_STRIDE = 272, STG_WAVE = 32 * STG_STRIDE;
static_assert(SHM_ATTN + NW * STG_WAVE <= RING_BYTES, "attention LDS");
#define KSWZ64(row, colB) ((row) * 128 + ((colB) ^ ((((row) >> 1) & 7) << 4)))
#define SBAR() __builtin_amdgcn_sched_barrier(0)
__device__ __forceinline__ int crow(int r, int hi) { return (r & 3) + 8 * (r >> 2) + 4 * hi; }
__device__ __forceinline__ void partialSM(f32x16& p0, f32x16& p1, float& m_reg, float& mn, float& alpha) {
  constexpr float C = SCALE * 1.4426950408889634f;
  float pmax = p0[0]; for (int r = 1; r < 16; ++r) pmax = fmaxf(pmax, p0[r]); for (int r = 0; r < 16; ++r) pmax = fmaxf(pmax, p1[r]);
  { auto rr = __builtin_amdgcn_permlane32_swap(__float_as_uint(pmax), __float_as_uint(pmax), false, false);
    pmax = fmaxf(__uint_as_float(rr[0]), __uint_as_float(rr[1])); }
  if (__builtin_expect(__all(pmax - m_reg <= THR / SCALE), 1)) { mn = m_reg; alpha = 1.f; }
  else { mn = fmaxf(m_reg, pmax); alpha = __builtin_amdgcn_exp2f((m_reg - mn) * C); m_reg = mn; }
  float mnC = -mn * C;
  for (int r = 0; r < 16; ++r) p0[r] = fmaf(p0[r], C, mnC); for (int r = 0; r < 16; ++r) p1[r] = fmaf(p1[r], C, mnC);
  for (int r = 0; r < 16; ++r) p0[r] = __builtin_amdgcn_exp2f(p0[r]);
}
__device__ __forceinline__ void finishSM(f32x16& p0, f32x16& p1, float alpha, float& l_reg, bf16x8& pa0, bf16x8& pa1, bf16x8& pa2, bf16x8& pa3) {
  for (int r = 0; r < 16; ++r) p1[r] = __builtin_amdgcn_exp2f(p1[r]);
  float ps = 0; for (int r = 0; r < 16; ++r) ps += p0[r]; for (int r = 0; r < 16; ++r) ps += p1[r];
  { auto rr = __builtin_amdgcn_permlane32_swap(__float_as_uint(ps), __float_as_uint(ps), false, false);
    ps = __uint_as_float(rr[0]) + __uint_as_float(rr[1]); }
  l_reg = l_reg * alpha + ps;
#define PK4(P, BASE, OUT) do { unsigned a0 = cvtpk(P[BASE + 0], P[BASE + 1]), a1 = cvtpk(P[BASE + 2], P[BASE + 3]);   \
    unsigned b0 = cvtpk(P[BASE + 4], P[BASE + 5]), b1 = cvtpk(P[BASE + 6], P[BASE + 7]);                              \
    auto r0 = __builtin_amdgcn_permlane32_swap(a0, b0, false, false); auto r1 = __builtin_amdgcn_permlane32_swap(a1, b1, false, false); \
    v4u w = {r0[0], r1[0], r0[1], r1[1]}; OUT = *reinterpret_cast<bf16x8*>(&w); } while (0)
  PK4(p0, 0, pa0); PK4(p0, 8, pa1); PK4(p1, 0, pa2); PK4(p1, 8, pa3);
#undef PK4
}
__device__ __forceinline__ void qkt(f32x16& p0, f32x16& p1, const char* Ks, const bf16x8* qr, int r32, int hi) {
  p0 = f32x16{}; p1 = f32x16{};
  for (int d0 = 0; d0 < 4; ++d0) { int cb = (d0 * 16 + hi * 8) * 2;
    bf16x8 b0 = *reinterpret_cast<const bf16x8*>(Ks + KSWZ64(r32, cb));
    bf16x8 b1 = *reinterpret_cast<const bf16x8*>(Ks + KSWZ64(32 + r32, cb));
    p0 = __builtin_amdgcn_mfma_f32_32x32x16_bf16(b0, qr[d0], p0, 0, 0, 0);
    p1 = __builtin_amdgcn_mfma_f32_32x32x16_bf16(b1, qr[d0], p1, 0, 0, 0); }
}
__device__ __forceinline__ int v_st(int k, int c) { const int kk = (k & ~0xC) | ((k & 4) << 1) | ((k & 8) >> 1); return ((kk >> 3) * 4 + (c >> 5)) * 512 + ((kk & 7) * 32 + (c & 31)) * 2; }
__device__ __forceinline__ int v_rd_base(int lane) { return ((lane & 3) << 3) | (((lane >> 2) & 3) << 6) | (((lane >> 4) & 1) << 5) | (((lane >> 5) & 1) << 8); }
constexpr int v_rd_off(int d0, int ks, int half) { return d0 * 512 + ks * 4096 + half * 2048; }
template <int OFF> __device__ __forceinline__ s16x4 tr_read(int vb) {
  s16x4 r; asm volatile("ds_read_b64_tr_b16 %0, %1 offset:%2" : "=&v"(r) : "v"(vb), "i"(OFF) : "memory"); return r;
}
template <int D0> __device__ __forceinline__ void pv_one(f32x16& od, int vb, bf16x8 pa0, bf16x8 pa1, bf16x8 pa2, bf16x8 pa3) {
  const s16x4 l0 = tr_read<v_rd_off(D0, 0, 0)>(vb), h0 = tr_read<v_rd_off(D0, 0, 1)>(vb), l1 = tr_read<v_rd_off(D0, 1, 0)>(vb), h1 = tr_read<v_rd_off(D0, 1, 1)>(vb);
  const s16x4 l2 = tr_read<v_rd_off(D0, 2, 0)>(vb), h2 = tr_read<v_rd_off(D0, 2, 1)>(vb), l3 = tr_read<v_rd_off(D0, 3, 0)>(vb), h3 = tr_read<v_rd_off(D0, 3, 1)>(vb);
  asm volatile("s_waitcnt lgkmcnt(0)" ::: "memory"); SBAR();
#define PK(L, H) (bf16x8){L[0], L[1], L[2], L[3], H[0], H[1], H[2], H[3]}
  od = __builtin_amdgcn_mfma_f32_32x32x16_bf16(pa0, PK(l0, h0), od, 0, 0, 0);
  od = __builtin_amdgcn_mfma_f32_32x32x16_bf16(pa1, PK(l1, h1), od, 0, 0, 0);
  od = __builtin_amdgcn_mfma_f32_32x32x16_bf16(pa2, PK(l2, h2), od, 0, 0, 0);
  od = __builtin_amdgcn_mfma_f32_32x32x16_bf16(pa3, PK(l3, h3), od, 0, 0, 0);
#undef PK
}
__device__ __forceinline__ void pv_d0(f32x16* o, int vb, bf16x8 pa0, bf16x8 pa1, bf16x8 pa2, bf16x8 pa3) {
  pv_one<0>(o[0], vb, pa0, pa1, pa2, pa3); pv_one<1>(o[1], vb, pa0, pa1, pa2, pa3); pv_one<2>(o[2], vb, pa0, pa1, pa2, pa3); pv_one<3>(o[3], vb, pa0, pa1, pa2, pa3);
}
template <int FIN>
__device__ __forceinline__ void attn_body(const bf16* __restrict__ Qb, const bf16* __restrict__ Kh, const bf16* __restrict__ Vh, float* __restrict__ Ob, int seq, char* lds,
                                          float lam, const float (&sub)[4], bf16* __restrict__ On) {
  const int tid = opaque_tid(), wid = tid >> 6, lane = tid & 63, r32 = lane & 31, hi = lane >> 5;
  char* V_lds = lds; char* K_lds = lds + 2 * SHM_V;
  float* ws = (float*)(lds + 2 * SHM_V + 2 * SHM_K) + wid * 64; float* li_l = ws; float* al_l = ws + 32;
  float m_reg = -1e30f, l_reg = 0; f32x16 o[4] = {}; bf16x8 qr[4];
  const bf16* Qw = Qb + (long)(wid * QBLK + r32) * LDQ + hi * 8;
#pragma unroll
  for (int d0 = 0; d0 < 4; ++d0) qr[d0] = *reinterpret_cast<const bf16x8*>(Qw + d0 * 16);
  const int sr = tid >> 4, sc = (tid & 15) * 8, vst0 = v_st(sr, sc), vst1 = v_st(32 + sr, sc);
  const int kr = tid >> 3, kc8 = (tid & 7) * 8, kst = KSWZ64(kr, kc8 * 2);
  const int vb0 = (int)(uintptr_t)V_lds + v_rd_base(lane);
  struct { bf16x8 vs0, vs1, ks0; } sr_[2];
#define SLOAD(i, k0) do { sr_[i].vs0 = *reinterpret_cast<const bf16x8*>(&Vh[(long)((k0) + sr) * LDK + sc]); sr_[i].vs1 = *reinterpret_cast<const bf16x8*>(&Vh[(long)((k0) + 32 + sr) * LDK + sc]); \
    sr_[i].ks0 = *reinterpret_cast<const bf16x8*>(&Kh[(long)((k0) + kr) * LDK + kc8]); } while (0)
#define SWRITE(b, i) do { *(bf16x8*)(V_lds + (b) * SHM_V + vst0) = sr_[i].vs0; *(bf16x8*)(V_lds + (b) * SHM_V + vst1) = sr_[i].vs1; \
    *(bf16x8*)(K_lds + (b) * SHM_K + kst) = sr_[i].ks0; } while (0)
#define SWAIT() asm volatile("s_waitcnt vmcnt(3)" ::: "memory")
#define RESC(a) do { if (__any((a) < 1.f)) { if (hi == 0) al_l[r32] = (a); asm volatile("s_waitcnt lgkmcnt(0)" ::: "memory"); \
    for (int d = 0; d < 4; ++d) for (int r = 0; r < 16; ++r) o[d][r] *= al_l[crow(r, hi)]; } } while (0)
  f32x16 pA0, pA1, pB0, pB1; float mnA, mnB, alA, alB; bf16x8 pa0, pa1, pa2, pa3; const int NT = seq / KVBLK;
  constexpr int SE = 0, SO = 1;
  SLOAD(SE, 0); asm volatile("s_waitcnt vmcnt(0)" ::: "memory"); SWRITE(0, SE); __syncthreads();
  qkt(pA0, pA1, K_lds, qr, r32, hi); partialSM(pA0, pA1, m_reg, mnA, alA);
  SLOAD(SO, KVBLK); if (2 < NT) SLOAD(SE, 2 * KVBLK);
  SWAIT(); SWRITE(1, SO); __syncthreads();
  for (int j = 1; j + 1 < NT; j += 2) {
    SBAR(); qkt(pB0, pB1, K_lds + SHM_K, qr, r32, hi);
    finishSM(pA0, pA1, alA, l_reg, pa0, pa1, pa2, pa3); SBAR();
    SLOAD(SO, (j + 2) * KVBLK); SBAR();
    pv_d0(o, vb0, pa0, pa1, pa2, pa3); partialSM(pB0, pB1, m_reg, mnB, alB);
    __syncthreads(); SWAIT(); SWRITE(0, SE);
    RESC(alB); __syncthreads();
    SBAR(); qkt(pA0, pA1, K_lds, qr, r32, hi);
    finishSM(pB0, pB1, alB, l_reg, pa0, pa1, pa2, pa3); SBAR();
    if (j + 3 < NT) SLOAD(SE, (j + 3) * KVBLK); SBAR();
    pv_d0(o, vb0 + (int)SHM_V, pa0, pa1, pa2, pa3); partialSM(pA0, pA1, m_reg, mnA, alA);
    __syncthreads(); SWAIT(); SWRITE(1, SO);
    RESC(alA); __syncthreads();
  }
  SBAR(); qkt(pB0, pB1, K_lds + SHM_K, qr, r32, hi);
  finishSM(pA0, pA1, alA, l_reg, pa0, pa1, pa2, pa3); SBAR();
  pv_d0(o, vb0, pa0, pa1, pa2, pa3); partialSM(pB0, pB1, m_reg, mnB, alB);
  __syncthreads(); RESC(alB);
  finishSM(pB0, pB1, alB, l_reg, pa0, pa1, pa2, pa3); SBAR();
  pv_d0(o, vb0 + (int)SHM_V, pa0, pa1, pa2, pa3);
  if (hi == 0) li_l[r32] = l_reg; asm volatile("s_waitcnt lgkmcnt(0)" ::: "memory");
  float rli[16];
#pragma unroll
  for (int r = 0; r < 16; ++r) rli[r] = __builtin_amdgcn_rcpf(li_l[crow(r, hi)]);
  char* stg = lds + SHM_ATTN + wid * STG_WAVE;
  if (FIN == 0) {
#pragma unroll
    for (int r = 0; r < 16; ++r) { const int orow = crow(r, hi);
#pragma unroll
      for (int d0 = 0; d0 < 4; ++d0) *(unsigned short*)(stg + orow * STG_STRIDE + (d0 * 32 + r32) * 2) = (unsigned short)(cvtpk(o[d0][r] * rli[r], 0.f) & 0xffffu); }
  } else {
#pragma unroll
    for (int r = 0; r < 16; ++r) { const int orow = crow(r, hi);
      float v[4]; float ss = 0.f;
#pragma unroll
      for (int d0 = 0; d0 < 4; ++d0) { const unsigned w0 = *(const unsigned short*)(stg + orow * STG_STRIDE + (d0 * 32 + r32) * 2); v[d0] = __uint_as_float(w0 << 16) - lam * (o[d0][r] * rli[r]); ss += v[d0] * v[d0]; }
      ss += __shfl_xor(ss, 1); ss += __shfl_xor(ss, 2); ss += __shfl_xor(ss, 4); ss += __shfl_xor(ss, 8); ss += __shfl_xor(ss, 16);
      const float rstd = 1.0f / sqrtf(ss * (1.0f / 128.0f) + NORM_EPS);
#pragma unroll
      for (int d0 = 0; d0 < 4; ++d0) *(unsigned short*)(stg + orow * STG_STRIDE + (d0 * 32 + r32) * 2) = (unsigned short)(cvtpk(v[d0] * rstd * sub[d0], 0.f) & 0xffffu); }
    asm volatile("s_waitcnt lgkmcnt(0)" ::: "memory");
    bf16* Onw = On + (long)(wid * QBLK) * LDO;
#pragma unroll
    for (int i = 0; i < 8; ++i) { const int chunk = lane + 64 * i, row = chunk >> 4, c16 = chunk & 15;
      const v4u w = *(const v4u*)(stg + row * STG_STRIDE + c16 * 16); *(v4u*)(Onw + (long)row * LDO + c16 * 8) = w; }
  }
#undef SLOAD
#undef SWRITE
#undef SWAIT
#undef RESC
}
}

template <int PART>
__device__ __forceinline__ void attn_phase(const Ptrs& P, int l, char* lds, int bid, int lane, int G) {
    const bf16* Q = (const bf16*)(P.ws + WS_R1 + 192 * MiB); const bf16* KB = (const bf16*)(P.ws + WS_KB); const bf16* VB = (const bf16*)(P.ws + WS_VB);
    bf16* ON = (bf16*)(P.ws + WS_R2);
    if (G != 256) return;
    int lq = l; asm volatile("" : "+s"(lq));
    const float lam_init = lq == 0 ? 0.2f : 0.35550906759097f;
    const float d1 = wave_sum(P.in(21)[lq * 64 + lane] * P.in(22)[lq * 64 + lane]), d2 = wave_sum(P.in(23)[lq * 64 + lane] * P.in(24)[lq * 64 + lane]);
    const float lam = expf(d1) - expf(d2) + lam_init;
    float sub[4];
#pragma unroll
    for (int d0 = 0; d0 < 4; ++d0) sub[d0] = P.in(25)[lq * 128 + d0 * 32 + (lane & 31)] * (1.0f - lam_init);
    const float nosub[4] = {0.f, 0.f, 0.f, 0.f};
    const int vcu = bid;
    const int nun = (PART == 0) ? (bid >= 128 ? 3 : 1) : 1;
    for (int ui = 0; ui < nun; ++ui) {
        int qrow0, kvrow0, seq, h;
        if (ui == 0) { const int u = vcu + 256 * PART, qb = u & 7; h = (u >> 3) & 7; const int b = u >> 6; qrow0 = MC + b * TSM + qb * 256; kvrow0 = MC + b * KVS; seq = KVS; }
        else { const int r = (bid - 128) * 2 + (ui - 1); h = r & 7; const int b = r >> 3; qrow0 = b * TCX; kvrow0 = qrow0; seq = TCX; }
        const bf16* q0 = Q + (size_t)qrow0 * 1024 + h * 128; const bf16* k0 = KB + (size_t)kvrow0 * 1024 + h * 128; const bf16* v0 = VB + (size_t)kvrow0 * 1024 + h * 128;
        att::attn_body<0>(q0, k0, v0, nullptr, seq, lds, 0.f, nosub, nullptr);
        __syncthreads();
        att::attn_body<1>(q0 + 64, k0 + 64, v0, nullptr, seq, lds, lam, sub, ON + (size_t)qrow0 * att::LDO + h * 128);
        __syncthreads();
    }
}

struct Args { const float* in[29]; float* out; unsigned char* ws; int ph_lo, ph_hi; };
__global__ void __launch_bounds__(NWAVES * 64, 2) mega_fwd(Args args) {
    extern __shared__ __attribute__((aligned(16))) unsigned char lds_raw[];
    LAS unsigned char* lds = (LAS unsigned char*)lds_raw;
    volatile LAS unsigned* MISC = (volatile LAS unsigned*)(lds + MISC_OFF);
    const int tid = threadIdx.x, lane = tid & 63, wave = __builtin_amdgcn_readfirstlane(tid >> 6);
    const int bid = (int)blockIdx.x;
    const int G = gridDim.x, gw = blockIdx.x * NWAVES + wave, NGW = G * NWAVES, gtid = blockIdx.x * (NWAVES * 64) + tid, NTH = G * NWAVES * 64;
    Ptrs P; P.tab = (const volatile LAS unsigned*)(lds + PTAB_OFF); P.out = args.out; P.ws = args.ws;
    unsigned char* ws = args.ws;
    for (int u = tid; u < (PTAB_OFF - LDSCTL_OFF) / 4; u += NWAVES * 64) ((LAS unsigned*)(lds + LDSCTL_OFF))[u] = 0u;
    if (tid < 29) { const unsigned long long pv = (unsigned long long)args.in[tid]; ((LAS unsigned*)(lds + PTAB_OFF))[2 * tid] = (unsigned)pv; ((LAS unsigned*)(lds + PTAB_OFF))[2 * tid + 1] = (unsigned)(pv >> 32); }
    __syncthreads();
    XcdBarrier bar = xcd_barrier_post((unsigned*)(ws + WS_CTL) + CW_BAR, MISC + 8);
    const int lo = args.ph_lo, hi = args.ph_hi;
#ifndef SITE_MASK
#define SITE_MASK 0xFFFFFFFFu
#endif
#define EN(s) ((SITE_MASK >> (s)) & 1u)
#ifndef REP_MASK
#define REP_MASK 0u
#endif
#define REPS(s) (((REP_MASK >> (s)) & 1u) ? 2 : 1)
#define IN(k) (lo <= (k) && (k) < hi)
#define SEAM(k) do { if (IN((k) + 1)) xcd_barrier(bar); } while (0)

    float* X = args.out;
    bf16* H = (bf16*)(ws + WS_H);
    bf16* D = (bf16*)(ws + WS_R2);
    const float* MOD = (const float*)(ws + WS_MOD);

    if (EN(0) && IN(0)) {
        mod_partials(P, lds, gw, NGW, wave, lane);
        if (NGW == 2048) { constexpr int C1 = 256 * 15; if (gw < 256) convert_weights(P, 0, lds, gw, 256, C1, wave, lane); else convert_weights(P, 0, lds, C1 + (gw - 256), 1792, CW_NIT, wave, lane); }
        else convert_weights(P, 0, lds, gw, NGW, CW_NIT, wave, lane);
        if (blockIdx.x == 0) { float* rc = (float*)(ws + WS_ROPE); float* rs = rc + 1024;
            for (int i = tid; i < 1024; i += NWAVES * 64) { const int pos = i >> 4, f = i & 15; const float fr = 1.0f / powf(10000.0f, (float)f / 16.0f), ang = (float)pos * fr; rc[i] = cosf(ang); rs[i] = sinf(ang); } }
        SEAM(0);
    }
    if (EN(1) && IN(1)) { mod_reduce(P, gtid, NTH); SEAM(1); }
    if (EN(2) && IN(2)) {
        thin_phase(lds, bid, tid, lane, wave, G, P.in(0), P.in(1), nullptr, (_Float16*)(ws + WS_X16), nullptr, D, H, nullptr, MOD, 0, 0.f, false, P.in(9), MOD, 1, 0, true);
        SEAM(2);
    }
    const Ptrs P0 = P;
#pragma unroll 1
    for (int l = 0; l < 2; ++l) {
        const int base = 3 + 12 * l;
#pragma unroll 1
        for (int f = 0; f < 2; ++f) {
            const int bid = opaque_bid();
#define MK_IDS const int tid = opaque_tid(), lane = tid & 63, wave = __builtin_amdgcn_readfirstlane(tid >> 6), gw = bid * NWAVES + wave, gtid = bid * (NWAVES * 64) + tid; (void)gw; (void)gtid; (void)lane; (void)wave
            unsigned long long ws_i = (unsigned long long)args.ws, x_i = (unsigned long long)args.out; asm volatile("" : "+s"(ws_i), "+s"(x_i));
            unsigned char* ws = (unsigned char*)(GAS unsigned char*)ws_i; float* X = (float*)(GAS float*)x_i;
            bf16* H = (bf16*)(ws + WS_H); bf16* D = (bf16*)(ws + WS_R2); _Float16* X16 = (_Float16*)(ws + WS_X16);
            const float* MODL = (const float*)(ws + WS_MOD) + (size_t)l * 9 * NMODC;
            Ptrs P; P.tab = P0.tab; P.out = X; P.ws = ws;
            if (EN(3) && IN(base + 9 * f)) {
                pg8::Gemm g{(const pg8::bf16_t*)H, (const pg8::bf16_t*)(ws + WS_W1T) + (size_t)f * NFF2 * DM, M, NFF2, DM}; pg8::StaticOrder S; S.init(M, NFF2, G, bid);
                pg8::EpiSwiGLU E{(pg8::bf16_t*)(ws + WS_R1), DFF};
                _Pragma("unroll 1") for (int rep = 0; rep < REPS(3); ++rep) { pg8::gemm_phase<pg8::EpiSwiGLU, pg8::StaticOrder, true, true>(lds, g, S, E); }
                SEAM(base + 9 * f);
            }
            if (EN(4) && IN(base + 9 * f + 1)) {
                pg8::Gemm g{(const pg8::bf16_t*)(ws + WS_R1), (const pg8::bf16_t*)(ws + WS_W2T) + (size_t)f * DM * DFF, M, DM, DFF}; pg8::StaticOrder S; S.init(M, DM, G, bid);
                pg8::EpiBf16P E{(pg8::bf16_t*)D, DM};
                _Pragma("unroll 1") for (int rep = 0; rep < REPS(4); ++rep) { pg8::gemm_phase<pg8::EpiBf16P, pg8::StaticOrder, true, true>(lds, g, S, E); }
                SEAM(base + 9 * f + 1);
            }
            if (EN(5) && IN(base + 9 * f + 2)) {
                MK_IDS;
                if (f == 0) {
                    thin_phase(lds, bid, tid, lane, wave, G, nullptr, nullptr, X16, X16, nullptr, D, H, P.in(10) + (size_t)(l * 3 + 0) * DM, MODL, 2, 0.5f, true,
                               P.in(9) + (size_t)(l * 3 + 1) * DM, MODL, 4, 3, true);
                    if (REPS(5) == 2) thin_phase(lds, bid, tid, lane, wave, G, nullptr, nullptr, X16, X16, nullptr, D, H, P.in(10), MODL, 2, 0.5f, false, P.in(9) + (size_t)(l * 3 + 1) * DM, MODL, 4, 3, true);
                    _Pragma("unroll 1") for (int rep = 0; rep < REPS(13); ++rep) convert_cache(P, l, gtid, NTH);
                } else {
                    const bool more = (l == 0);
                    thin_phase(lds, bid, tid, lane, wave, G, nullptr, nullptr, X16, X16, more ? nullptr : X, D, H, P.in(10) + (size_t)(l * 3 + 2) * DM, MODL, 8, 0.5f, true,
                               P.in(9) + (size_t)((l + 1) * 3 + 0) * DM, MODL + 9 * NMODC, 1, 0, more);
                    if (more) { _Pragma("unroll 1") for (int rep = 0; rep < REPS(14); ++rep) convert_weights(P, l + 1, lds, gw, NGW, CW_NIT, wave, lane); }
                }
                SEAM(base + 9 * f + 2);
            }
            if (f == 1) break;
            if (EN(6) && IN(base + 3)) {
                pg8::Gemm g{(const pg8::bf16_t*)H, (const pg8::bf16_t*)(ws + WS_WINT), M, NIN, DM}; pg8::StaticOrder S; S.init(M, NIN, G, bid);
                float* ock = X + (size_t)M * DM + (size_t)l * 256 * 1024; float* ocv = ock + (size_t)MC * 1024 * 2;
                pg8::EpiWin E{(pg8::bf16_t*)(ws + WS_R1), (pg8::bf16_t*)(ws + WS_R1 + 96 * MiB), (pg8::bf16_t*)(ws + WS_R1 + 192 * MiB), (pg8::bf16_t*)(ws + WS_KB), (pg8::bf16_t*)(ws + WS_VB),
                              (pg8::bf16_t*)(ws + WS_GM), ock, ocv, (const float*)(ws + WS_ROPE), (const float*)(ws + WS_ROPE) + 1024};
                _Pragma("unroll 1") for (int rep = 0; rep < REPS(6); ++rep) { pg8::gemm_phase<pg8::EpiWin, pg8::StaticOrder, true, true>(lds, g, S, E); }
                SEAM(base + 3);
            }
            if (IN(base + 4)) {
                MK_IDS;
                if (EN(7)) { _Pragma("unroll 1") for (int rep = 0; rep < REPS(7); ++rep) lru_phase<1>(P, l, lds, bid, tid, lane, wave, G); }
                if (EN(8)) { _Pragma("unroll 1") for (int rep = 0; rep < REPS(8); ++rep) attn_phase<0>(P, l, (char*)lds_raw, bid, lane, G); }
                SEAM(base + 4);
            }
            if (IN(base + 5)) {
                MK_IDS;
                if (EN(7)) { _Pragma("unroll 1") for (int rep = 0; rep < REPS(9); ++rep) lru_phase<2>(P, l, lds, bid, tid, lane, wave, G); }
                if (EN(8)) { _Pragma("unroll 1") for (int rep = 0; rep < REPS(8); ++rep) attn_phase<1>(P, l, (char*)lds_raw, bid, lane, G); }
                SEAM(base + 5);
            }
            if (EN(10) && IN(base + 6)) {
                _Pragma("unroll 1") for (int rep = 0; rep < REPS(10); ++rep) {
                  pg8::Gemm g1{(const pg8::bf16_t*)(ws + WS_HF), (const pg8::bf16_t*)(ws + WS_PLRUT), M, DM, DM};
                  pg8::Gemm g2{(const pg8::bf16_t*)(ws + WS_R2), (const pg8::bf16_t*)(ws + WS_PATTNT), M, DM, DM};
                  pg8::StaticOrder S; S.init(M, DM, G, bid);
                  pg8::EpiGateM E{(const pg8::bf16_t*)(ws + WS_GM), (pg8::bf16_t*)H};
                  pg8::gemm_phase_dual<pg8::EpiGateM, pg8::StaticOrder>(lds, g1, g2, 16, S, E); }
                SEAM(base + 6);
            }
            if (EN(11) && IN(base + 7)) {
                pg8::Gemm g{(const pg8::bf16_t*)H, (const pg8::bf16_t*)(ws + WS_WOUTT), M, DM, DM}; pg8::StaticOrder S; S.init(M, DM, G, bid);
                pg8::EpiBf16P E{(pg8::bf16_t*)D, DM};
                _Pragma("unroll 1") for (int rep = 0; rep < REPS(11); ++rep) { pg8::gemm_phase<pg8::EpiBf16P, pg8::StaticOrder, true, true>(lds, g, S, E); }
                SEAM(base + 7);
            }
            if (EN(12) && IN(base + 8)) {
                MK_IDS;
                thin_phase(lds, bid, tid, lane, wave, G, nullptr, nullptr, X16, X16, nullptr, D, H, P.in(10) + (size_t)(l * 3 + 1) * DM, MODL, 5, 1.0f, true,
                           P.in(9) + (size_t)(l * 3 + 2) * DM, MODL, 7, 6, true);
                SEAM(base + 8);
            }
        }
    }
#undef MK_IDS
#undef IN
#undef SEAM
}

#ifndef MK_SPLIT
#define MK_SPLIT 0
#endif
extern "C" void kernel_launch(void* const* d_in, const int* in_sizes, int n_in, void* d_out, int out_size, void* d_ws, size_t ws_size, hipStream_t stream) {
    static int grid = 0;
    if (grid == 0) {
        if (n_in != 29 || ws_size < WS_END) { fprintf(stderr, "kernel_launch: need 29 inputs and >= %zu bytes of workspace; got %d, %zu\n", (size_t)WS_END, n_in, ws_size); grid = -1; return; }
        int dev = 0, cus = 0, per_cu = 0;
        if (hipGetDevice(&dev) != hipSuccess || hipDeviceGetAttribute(&cus, hipDeviceAttributeMultiprocessorCount, dev) != hipSuccess) { grid = -1; return; }
        if (hipFuncSetAttribute((const void*)mega_fwd, hipFuncAttributeMaxDynamicSharedMemorySize, LDS_BYTES) != hipSuccess) { fprintf(stderr, "kernel_launch: hipFuncSetAttribute failed\n"); grid = -1; return; }
        if (hipOccupancyMaxActiveBlocksPerMultiprocessor(&per_cu, (const void*)mega_fwd, NWAVES * 64, LDS_BYTES) != hipSuccess || per_cu < 1) { fprintf(stderr, "kernel_launch: occupancy query says %d\n", per_cu); (void)hipGetLastError(); grid = -1; return; }
        grid = cus;
    }
    if (grid < 0) return;
    (void)hipMemsetAsync((char*)d_ws + WS_CTL, 0, CTL_ZERO_BYTES, stream);
    Args a{};
    for (int i = 0; i < 29; ++i) a.in[i] = (const float*)d_in[i];
    a.out = (float*)d_out; a.ws = (unsigned char*)d_ws;
#if MK_SPLIT
    for (int p = 0; p < NPHASE; ++p) { a.ph_lo = p; a.ph_hi = p + 1; hipLaunchKernelGGL(mega_fwd, dim3(grid), dim3(NWAVES * 64), LDS_BYTES, stream, a); }
#else
    a.ph_lo = 0; a.ph_hi = NPHASE;
    hipLaunchKernelGGL(mega_fwd, dim3(grid), dim3(NWAVES * 64), LDS_BYTES, stream, a);
#endif
    const hipError_t le = hipPeekAtLastError();
    if (le != hipSuccess) fprintf(stderr, "kernel_launch: launch failed: %s\n", hipGetErrorName(le));
}
```
